# Optimizing an MI355X kernel written in HIP

```python
import jax, jax.numpy as jnp
from jax import lax
import numpy as np

D_MODEL = 1024
BATCH = 16
SEQ = 4096
DEPTH = 1

CHUNK = 64
M_HEADS = 4
M_HEAD_DIM = 256
M_WIDTH = M_HEADS * M_HEAD_DIM
SB_HEADS = 8
SB_HEAD_DIM = 128
SB_WIDTH = SB_HEADS * SB_HEAD_DIM
CONV_WIDTH = 4
Q_BLOCK = 128
N_BRANCH = 2
EPS = 1e-6
SPLIT_SIZES = (M_WIDTH, M_WIDTH, M_WIDTH,
               M_HEADS, M_HEADS,
               M_WIDTH, M_WIDTH,
               SB_WIDTH, SB_WIDTH, SB_WIDTH,
               SB_WIDTH,
               N_BRANCH * D_MODEL)
IN_COLS = 5 * M_WIDTH + 2 * M_HEADS + 4 * SB_WIDTH + N_BRANCH * D_MODEL

kernel_name = "hybrid_mlstm_stickbreaking_gated_merge"


def rmsnorm(x, w):
    xf = x.astype(jnp.float32)
    y = xf * lax.rsqrt(jnp.mean(xf * xf, axis=-1, keepdims=True) + EPS)
    return (y * w.astype(jnp.float32)).astype(x.dtype)


def causal_depthwise_conv(x, w, b):
    k = w.shape[0]
    out = lax.conv_general_dilated(
        x, w[:, None, :].astype(x.dtype), window_strides=(1,), padding=[(k - 1, 0)],
        dimension_numbers=("NWC", "WIO", "NWC"), feature_group_count=x.shape[-1])
    return out + b


def to_heads(x, n_heads):
    b, s, _ = x.shape
    return x.reshape(b, s, n_heads, -1).transpose(0, 2, 1, 3)


def mlstm_chunkwise(q, k, v, log_i, log_f):
    b_, h_, s_, d_ = q.shape
    nc = s_ // CHUNK
    f32 = jnp.float32

    def chunked(a):
        a = a.reshape(b_, h_, nc, CHUNK, *a.shape[3:])
        return jnp.moveaxis(a, 2, 0)

    qc = chunked(q.astype(f32))
    kc = chunked(k.astype(f32) * (d_ ** -0.5))
    vc = chunked(v.astype(f32))
    ic = chunked(log_i.astype(f32))
    fc = chunked(log_f.astype(f32))
    tril = jnp.tril(jnp.ones((CHUNK, CHUNK), dtype=bool))

    def step(carry, xs):
        C, n, m = carry
        qb, kb, vb, ib, fb = xs
        bcum = jnp.cumsum(fb, axis=-1)
        dmat = bcum[..., :, None] - bcum[..., None, :] + ib[..., None, :]
        dmat = jnp.where(tril, dmat, -jnp.inf)
        inter = bcum + m[..., None]
        m_t = jnp.maximum(inter, jnp.max(dmat, axis=-1))
        w_intra = jnp.exp(dmat - m_t[..., None])
        w_inter = jnp.exp(inter - m_t)
        scores = jnp.einsum('bhtd,bhsd->bhts', qb, kb) * w_intra
        num = (jnp.einsum('bhts,bhse->bhte', scores, vb)
               + w_inter[..., None] * jnp.einsum('bhtd,bhde->bhte', qb, C))
        den = jnp.sum(scores, axis=-1) + w_inter * jnp.einsum('bhtd,bhd->bht', qb, n)
        h = num / jnp.maximum(jnp.abs(den), jnp.exp(-m_t))[..., None]
        b_last = bcum[..., -1]
        decay = b_last[..., None] - bcum + ib
        m_new = jnp.maximum(b_last + m, jnp.max(decay, axis=-1))
        ws = jnp.exp(decay - m_new[..., None])
        carry_scale = jnp.exp(b_last + m - m_new)
        kw = kb * ws[..., None]
        C_new = carry_scale[..., None, None] * C + jnp.einsum('bhsd,bhse->bhde', kw, vb)
        n_new = carry_scale[..., None] * n + jnp.sum(kw, axis=2)
        return (C_new, n_new, m_new), h

    init = (jnp.zeros((b_, h_, d_, d_), f32), jnp.zeros((b_, h_, d_), f32),
            jnp.zeros((b_, h_), f32))
    _, hs = lax.scan(step, init, (qc, kc, vc, ic, fc))
    return jnp.moveaxis(hs, 0, 2).reshape(b_, h_, s_, d_)


def stick_breaking_attention(q, k, v):
    _, _, s_, d_ = q.shape
    scale = d_ ** -0.5
    outs = []
    for blk in range(s_ // Q_BLOCK):
        t0, t1 = blk * Q_BLOCK, (blk + 1) * Q_BLOCK
        qb, kb, vb = q[:, :, t0:t1], k[:, :, :t1], v[:, :, :t1]
        z = jnp.einsum('bhtd,bhsd->bhts', qb, kb).astype(jnp.float32) * scale
        t_idx = t0 + jnp.arange(Q_BLOCK)[:, None]
        s_idx = jnp.arange(t1)[None, :]
        causal = s_idx < t_idx
        log_beta = jax.nn.log_sigmoid(z)
        log_1mb = jnp.where(causal, jax.nn.log_sigmoid(-z), 0.0)
        between = lax.cumsum(log_1mb, axis=3, reverse=True) - log_1mb
        a = jnp.where(causal, jnp.exp(log_beta + between), 0.0)
        outs.append(jnp.einsum('bhts,bhsd->bhtd', a.astype(v.dtype), vb))
    return jnp.concatenate(outs, axis=2)


def setup_inputs(seed: int = 0) -> dict:
    key = jax.random.key(seed)
    ks = jax.random.split(key, 13)
    f32 = jnp.float32
    x = jax.random.normal(ks[0], (BATCH, SEQ, D_MODEL), f32)
    norm_w = 1.0 + 0.02 * jax.random.normal(ks[1], (D_MODEL,), f32)
    w_in = jax.random.normal(ks[2], (D_MODEL, IN_COLS), f32) * D_MODEL ** -0.5
    b_in = 0.02 * jax.random.normal(ks[3], (IN_COLS,), f32)
    f_start = 3 * M_WIDTH + M_HEADS
    b_in = b_in.at[f_start:f_start + M_HEADS].add(jnp.linspace(3.0, 6.0, M_HEADS, dtype=f32))
    conv_w = jax.random.normal(ks[4], (CONV_WIDTH, 2 * M_WIDTH), f32) * CONV_WIDTH ** -0.5
    conv_b = 0.02 * jax.random.normal(ks[5], (2 * M_WIDTH,), f32)
    mlstm_norm_w = 1.0 + 0.02 * jax.random.normal(ks[6], (M_WIDTH,), f32)
    sb_q_norm_w = 1.0 + 0.02 * jax.random.normal(ks[7], (SB_HEAD_DIM,), f32)
    sb_k_norm_w = 1.0 + 0.02 * jax.random.normal(ks[8], (SB_HEAD_DIM,), f32)
    w_proj_m = jax.random.normal(ks[9], (M_WIDTH, D_MODEL), f32) * M_WIDTH ** -0.5
    w_proj_s = jax.random.normal(ks[10], (SB_WIDTH, D_MODEL), f32) * SB_WIDTH ** -0.5
    w_out = jax.random.normal(ks[11], (D_MODEL, D_MODEL), f32) * D_MODEL ** -0.5
    return {"x": x, "norm_w": norm_w, "w_in": w_in, "b_in": b_in,
            "conv_w": conv_w, "conv_b": conv_b, "mlstm_norm_w": mlstm_norm_w,
            "sb_q_norm_w": sb_q_norm_w, "sb_k_norm_w": sb_k_norm_w,
            "w_proj_m": w_proj_m, "w_proj_s": w_proj_s, "w_out": w_out}


def reference(x, norm_w, w_in, b_in, conv_w, conv_b, mlstm_norm_w,
              sb_q_norm_w, sb_k_norm_w, w_proj_m, w_proj_s, w_out):
    b_, s_, _ = x.shape
    split_at = [int(c) for c in np.cumsum(SPLIT_SIZES)[:-1]]
    for _layer in range(DEPTH):
        h = rmsnorm(x, norm_w)
        proj = jnp.einsum('bsd,de->bse', h, w_in) + b_in
        (mq, mk, mv, mi, mf, mo, mz, sq, sk, sv, sz, gates) = jnp.split(proj, split_at, axis=-1)

        qk = jax.nn.silu(causal_depthwise_conv(jnp.concatenate([mq, mk], axis=-1), conv_w, conv_b))
        mq_c, mk_c = jnp.split(qk, 2, axis=-1)
        log_i = mi.astype(jnp.float32).transpose(0, 2, 1)
        log_f = jax.nn.log_sigmoid(mf.astype(jnp.float32)).transpose(0, 2, 1)
        hm = mlstm_chunkwise(to_heads(mq_c, M_HEADS), to_heads(mk_c, M_HEADS),
                             to_heads(mv, M_HEADS), log_i, log_f)
        hm = rmsnorm(hm.transpose(0, 2, 1, 3), mlstm_norm_w.reshape(M_HEADS, M_HEAD_DIM))
        y_m = (hm.reshape(b_, s_, M_WIDTH).astype(x.dtype)
               * jax.nn.sigmoid(mo) * jax.nn.silu(mz))

        qs = rmsnorm(to_heads(sq, SB_HEADS), sb_q_norm_w)
        ks_ = rmsnorm(to_heads(sk, SB_HEADS), sb_k_norm_w)
        os_ = stick_breaking_attention(qs, ks_, to_heads(sv, SB_HEADS))
        y_s = os_.transpose(0, 2, 1, 3).reshape(b_, s_, SB_WIDTH) * jax.nn.silu(sz)

        g_m, g_s = jnp.split(jax.nn.sigmoid(gates), N_BRANCH, axis=-1)
        merged = (g_m * jnp.einsum('bse,ed->bsd', y_m, w_proj_m)
                  + g_s * jnp.einsum('bse,ed->bsd', y_s, w_proj_s))
        x = x + jnp.einsum('bsd,de->bse', merged, w_out)
    return x
```

```cpp
#include <hip/hip_runtime.h>
#include <hip/hip_cooperative_groups.h>
#include <cstdio>
#include <cstdint>
namespace cg = cooperative_groups;

#ifndef MK_N_LAUNCHES
#define MK_N_LAUNCHES 1
#endif

#define DI __device__ __forceinline__
#define LAS __attribute__((address_space(3)))
typedef unsigned short u16;
typedef short bf16x8 __attribute__((ext_vector_type(8)));
typedef short bf16x4 __attribute__((ext_vector_type(4)));
typedef float f32x4 __attribute__((ext_vector_type(4)));
typedef unsigned u32x4 __attribute__((ext_vector_type(4)));
typedef unsigned u32x2 __attribute__((ext_vector_type(2)));

constexpr int DM = 1024, NB = 16, SEQ = 4096, MT = NB * SEQ;
constexpr int IN_COLS = 11272;
constexpr int C_MQ = 0, C_MI = 3072, C_MO = 3080, C_MZ = 4104, C_SQ = 5128, C_SZ = 8200, C_G = 9224;
constexpr int N1 = 9216;
constexpr int NALL = 11264;
constexpr float EPS = 1e-6f;
constexpr size_t MiB = 1u << 20;
constexpr size_t TS = (size_t)MT * DM;
constexpr size_t WS_BAR = 4096, WS_BAR_BYTES = 65536;
constexpr size_t WS_WALL = 1 * MiB, WS_WPM = 23 * MiB, WS_WPS = 25 * MiB, WS_WOUT = 27 * MiB, WS_BIAS = 29 * MiB, WS_IGF = 30 * MiB, WS_SSQ = 32 * MiB,
                 WS_H = 40 * MiB, WS_B6 = 168 * MiB, WS_END = 936 * MiB;
constexpr int LDS_BYTES = 143360;
constexpr int NPH = 6;
#ifndef AT_SHL
#define AT_SHL 0x100
#endif

DI float bf2f(u16 b) { return __uint_as_float(((unsigned)b) << 16); }
DI float bflo(unsigned w) { return __uint_as_float(w << 16); }
DI float bfhi(unsigned w) { return __uint_as_float(w & 0xffff0000u); }
typedef __bf16 bf16v2_t __attribute__((ext_vector_type(2)));
DI unsigned cvt_pk_bf16(float lo, float hi) { bf16v2_t v = {(__bf16)lo, (__bf16)hi}; return __builtin_bit_cast(unsigned, v); }
DI u16 f2bf(float f) { return (u16)(cvt_pk_bf16(f, 0.f) & 0xffffu); }
DI float sigmoidf_(float x) { return __builtin_amdgcn_rcpf(1.0f + __expf(-x)); }
DI float siluf_(float x) { return x * sigmoidf_(x); }
DI float softplus_fast(float z) { return fmaxf(z, 0.f) + __logf(1.0f + __expf(-fabsf(z))); }
DI float wave_sum(float v) {
#pragma unroll
    for (int o = 1; o < 64; o <<= 1) v += __shfl_xor(v, o);
    return v;
}
DI float wave_max(float v) {
#pragma unroll
    for (int o = 1; o < 64; o <<= 1) v = fmaxf(v, __shfl_xor(v, o));
    return v;
}
template <int CTRL> DI float dpp_mov0(float v) { return __builtin_bit_cast(float, __builtin_amdgcn_update_dpp(0, __builtin_bit_cast(int, v), CTRL, 0xF, 0xF, true)); }
DI float row16_sum(float v) { v += dpp_mov0<0xB1>(v); v += dpp_mov0<0x4E>(v); v += dpp_mov0<0x141>(v); v += dpp_mov0<0x140>(v); return v; }
DI float row16_suffix(float v) { v += dpp_mov0<AT_SHL + 1>(v); v += dpp_mov0<AT_SHL + 2>(v); v += dpp_mov0<AT_SHL + 4>(v); v += dpp_mov0<AT_SHL + 8>(v); return v; }
typedef __bf16 bf16v2_d __attribute__((ext_vector_type(2)));
DI float dot2sq(unsigned w, float acc) { const bf16v2_d v = __builtin_bit_cast(bf16v2_d, w); return __builtin_amdgcn_fdot2_f32_bf16(v, v, acc, false); }
DI float sumsq8(u32x4 w, float acc) { return dot2sq(w.w, dot2sq(w.z, dot2sq(w.y, dot2sq(w.x, acc)))); }
#define MFMA16(a, b, c) __builtin_amdgcn_mfma_f32_16x16x32_bf16(a, b, c, 0, 0, 0)
#define LDS_FENCE() asm volatile("s_waitcnt lgkmcnt(0)" ::: "memory")

DI bf16x8 row_frag(const LAS u16* base, int ld, int row, int k) { return *(const LAS bf16x8*)(base + row * ld + k); }
DI bf16x8 tr_frag(const LAS u16* base, int ld, int krow0, int col0, int lane) {
    const int g = lane >> 4, q = (lane & 15) >> 2, p = lane & 3;
    const LAS u16* a0 = base + (krow0 + 8 * g + q) * ld + col0 + 4 * p;
    const bf16x4 lo = __builtin_amdgcn_ds_read_tr16_b64_v4i16((LAS bf16x4*)a0);
    const bf16x4 hi = __builtin_amdgcn_ds_read_tr16_b64_v4i16((LAS bf16x4*)(a0 + 4 * ld));
    return (bf16x8){lo[0], lo[1], lo[2], lo[3], hi[0], hi[1], hi[2], hi[3]};
}

namespace pg8 {
constexpr int BM = 256, BK = 64, HALF = 128, HTB = HALF * BK * 2, STAGE_BYTES = 8 * HTB, NXCD = 8, WGM = 8;
__host__ __device__ __forceinline__ int lds_byte(int r, int c) { const int st = (r >> 4) * 2 + (c >> 5), rr = r & 15, cc = c & 31, ob = rr * 64 + cc * 2; return st * 1024 + (ob ^ (((ob >> 9) & 1) << 5)); }
__host__ __device__ __forceinline__ void stage_rc(int b, int& R, int& C) { const int st = b / 1024, sb = b % 1024, swz = sb ^ (((sb >> 9) & 1) << 5); R = (st >> 1) * 16 + swz / 64; C = (st & 1) * 32 + (swz % 64) / 2; }
__host__ __device__ __forceinline__ int perm32(int rho) { const int n = rho >> 4, i = rho & 15; return 8 * (i >> 2) + 4 * n + (i & 3); }
struct Unit { int pm, pn; };
struct Gemm { const u16* A; const u16* Bt; int M, N, K; };
struct StaticOrder {
    int nM, nN, nwg, G, c;
    __host__ __device__ void init(int M, int N, int G_, int c_) { nM = M / BM; nN = N / BM; nwg = nM * nN; G = G_; c = c_; }
    __host__ __device__ bool next(int i, Unit& u) const {
        const long L = (long)i * G + c; if (L >= nwg) return false;
        int wgid = (int)L; { const int q = nwg / NXCD, r = nwg % NXCD, xcd = wgid % NXCD, off = wgid / NXCD; wgid = (xcd < r ? xcd * (q + 1) : r * (q + 1) + (xcd - r) * q) + off; }
        const int nig = WGM * nN, gid = wgid / nig, fm = gid * WGM, gsz = (nM - fm) < WGM ? (nM - fm) : WGM;
        u.pm = fm + ((wgid % nig) % gsz); u.pn = (wgid % nig) / gsz; return true;
    }
};
template <class Epi, class Sched, bool ALIGN_EPI = true, bool SP2 = true>
__device__ __forceinline__ void gemm_phase(LAS unsigned char* lds, const Gemm g, const Sched& S, const Epi& E) {
    const int tid = threadIdx.x, wid = __builtin_amdgcn_readfirstlane(tid >> 6), lane = tid & 63, wr = wid >> 2, wc = wid & 3, fr = lane & 15, fq = lane >> 4;
    const int K = g.K, nt = K / BK;
    unsigned voffA[2], voffB[2];
#pragma unroll
    for (int i = 0; i < 2; ++i) { int R, C; stage_rc(tid * 16 + i * 8192, R, C); const int Rb = Epi::PERM ? ((R & ~31) + perm32(R & 31)) : R;
        voffA[i] = (unsigned)(R * K + C) * 2u; voffB[i] = (unsigned)(Rb * K + C) * 2u; }
    const size_t kstep = (size_t)(BK * 2);
    const size_t hstep = (size_t)HALF * K * 2;
    const size_t tstep = 2 * hstep;
    const unsigned ldsw = (unsigned)wid * 1024u;
    const int aoff = lds_byte(wr * 64 + fr, fq * 8), boff = lds_byte(wc * 32 + fr, fq * 8);
#define PG8_SA(b, h) (((b) * 2 + (h)) * HTB)
#define PG8_SB(b, h) ((4 + (b) * 2 + (h)) * HTB)
#define PG8_STAGE(bufoff, gbase, voff) do { _Pragma("unroll") for (int _i = 0; _i < 2; ++_i) \
        __builtin_amdgcn_global_load_lds((const unsigned*)((const char*)(gbase) + (voff)[_i]), (LAS unsigned*)(lds + (bufoff) + ldsw + _i * 8192), 16, 0, 0); } while (0)
#define PG8_LDA(dst, b, h) do { _Pragma("unroll") for (int m = 0; m < 4; ++m) _Pragma("unroll") for (int k = 0; k < 2; ++k) dst[m][k] = *(const LAS bf16x8*)(lds + PG8_SA(b, h) + aoff + m * 2048 + k * 1024); } while (0)
#define PG8_LDB(dst, b, h) do { _Pragma("unroll") for (int n = 0; n < 2; ++n) _Pragma("unroll") for (int k = 0; k < 2; ++k) dst[n][k] = *(const LAS bf16x8*)(lds + PG8_SB(b, h) + boff + n * 2048 + k * 1024); } while (0)
#define PG8_MMA(ai, bj, At, Bt) do { __builtin_amdgcn_s_setprio(1); _Pragma("unroll") for (int m = 0; m < 4; ++m) _Pragma("unroll") for (int n = 0; n < 2; ++n) _Pragma("unroll") for (int k = 0; k < 2; ++k) \
        acc[ai][bj][m][n] = __builtin_amdgcn_mfma_f32_16x16x32_bf16(Bt[n][k], At[m][k], acc[ai][bj][m][n], 0, 0, 0); __builtin_amdgcn_s_setprio(0); } while (0)
#define PG8_WAIT_V(n) asm volatile("s_waitcnt vmcnt(" #n ")" ::: "memory")
#define PG8_WAIT_L(n) asm volatile("s_waitcnt lgkmcnt(" #n ")" ::: "memory")
#define PG8_BAR __builtin_amdgcn_s_barrier()
#define PG8_SCHED __builtin_amdgcn_sched_barrier(0)
    Unit cur, nxt; int ui = 0;
    if (!S.next(0, cur)) return;
    f32x4 acc[2][2][4][2];
#pragma unroll
    for (int a = 0; a < 2; ++a)
#pragma unroll
        for (int b = 0; b < 2; ++b)
#pragma unroll
            for (int m = 0; m < 4; ++m)
#pragma unroll
                for (int n = 0; n < 2; ++n) acc[a][b][m][n] = (f32x4){0.f, 0.f, 0.f, 0.f};
    bf16x8 At[4][2], B0[2][2], B1[2][2];
    const char* cA = (const char*)g.A + (size_t)cur.pm * tstep; const char* cB = (const char*)g.Bt + (size_t)cur.pn * tstep;
    if constexpr (SP2) {
        PG8_STAGE(PG8_SB(0, 0), cB, voffB); PG8_STAGE(PG8_SB(0, 1), cB + hstep, voffB); PG8_STAGE(PG8_SA(0, 0), cA, voffA); PG8_STAGE(PG8_SA(0, 1), cA + hstep, voffA);
        if (wr == 1) PG8_BAR;
        PG8_WAIT_V(2); PG8_BAR;
        PG8_STAGE(PG8_SB(1, 0), cB + kstep, voffB); PG8_STAGE(PG8_SA(1, 0), cA + kstep, voffA); PG8_STAGE(PG8_SB(1, 1), cB + hstep + kstep, voffB);
        PG8_WAIT_V(6); PG8_BAR;
    } else {
        PG8_STAGE(PG8_SB(0, 0), cB, voffB); PG8_STAGE(PG8_SA(0, 0), cA, voffA); PG8_STAGE(PG8_SB(0, 1), cB + hstep, voffB); PG8_STAGE(PG8_SA(0, 1), cA + hstep, voffA);
        if (wr == 1) PG8_BAR;
        PG8_WAIT_V(4); PG8_BAR;
        PG8_STAGE(PG8_SB(1, 0), cB + kstep, voffB); PG8_STAGE(PG8_SA(1, 0), cA + kstep, voffA); PG8_STAGE(PG8_SB(1, 1), cB + hstep + kstep, voffB);
        PG8_WAIT_V(6); PG8_BAR;
    }
    for (;;) {
        const bool has_next = S.next(ui + 1, nxt);
        const char* nA = has_next ? (const char*)g.A + (size_t)nxt.pm * tstep : cA; const char* nB = has_next ? (const char*)g.Bt + (size_t)nxt.pn * tstep : cB;
        for (int t = 0; t < nt; t += 2) {
            const bool last = (t == nt - 2);
            const char* a1 = cA + (size_t)(t + 1) * kstep;
            const char* a2 = last ? nA : cA + (size_t)(t + 2) * kstep; const char* b2 = last ? nB : cB + (size_t)(t + 2) * kstep;
            const char* a3 = a2 + kstep; const char* b3 = b2 + kstep;
            if constexpr (SP2) {
            PG8_LDB(B0, 0, 0); PG8_LDB(B1, 0, 1); PG8_SCHED; PG8_LDA(At, 0, 0); PG8_STAGE(PG8_SA(1, 1), a1 + hstep, voffA);
            PG8_WAIT_V(8); PG8_WAIT_L(0); PG8_BAR; PG8_MMA(0, 0, At, B0); PG8_MMA(0, 1, At, B1); PG8_BAR; PG8_SCHED;
            PG8_LDA(At, 0, 1); PG8_STAGE(PG8_SB(0, 0), b2, voffB); PG8_STAGE(PG8_SB(0, 1), b2 + hstep, voffB); PG8_STAGE(PG8_SA(0, 0), a2, voffA);
            PG8_WAIT_V(8); PG8_WAIT_L(0); PG8_BAR; PG8_MMA(1, 0, At, B0); PG8_MMA(1, 1, At, B1); PG8_BAR; PG8_SCHED;
            PG8_LDB(B0, 1, 0); PG8_LDB(B1, 1, 1); PG8_SCHED; PG8_LDA(At, 1, 0); PG8_STAGE(PG8_SA(0, 1), a2 + hstep, voffA);
            PG8_WAIT_V(8); PG8_WAIT_L(0); PG8_BAR; PG8_MMA(0, 0, At, B0); PG8_MMA(0, 1, At, B1); PG8_BAR; PG8_SCHED;
            PG8_LDA(At, 1, 1); PG8_STAGE(PG8_SB(1, 0), b3, voffB); PG8_STAGE(PG8_SB(1, 1), b3 + hstep, voffB); PG8_STAGE(PG8_SA(1, 0), a3, voffA);
            PG8_WAIT_V(8); PG8_WAIT_L(0); PG8_BAR; PG8_MMA(1, 0, At, B0); PG8_MMA(1, 1, At, B1); PG8_BAR; PG8_SCHED;
            } else {
            PG8_LDB(B0, 0, 0); PG8_SCHED; PG8_LDA(At, 0, 0); PG8_STAGE(PG8_SA(1, 1), a1 + hstep, voffA);
            PG8_WAIT_L(8); PG8_BAR; PG8_WAIT_L(0); PG8_MMA(0, 0, At, B0); PG8_BAR; PG8_SCHED;
            PG8_LDB(B1, 0, 1); PG8_STAGE(PG8_SB(0, 0), b2, voffB);
            PG8_BAR; PG8_WAIT_L(0); PG8_MMA(0, 1, At, B1); PG8_BAR;
            PG8_LDA(At, 0, 1); PG8_STAGE(PG8_SA(0, 0), a2, voffA);
            PG8_BAR; PG8_WAIT_L(0); PG8_MMA(1, 0, At, B0); PG8_BAR; PG8_SCHED;
            PG8_STAGE(PG8_SB(0, 1), b2 + hstep, voffB);
            PG8_WAIT_V(6); PG8_BAR; PG8_MMA(1, 1, At, B1); PG8_BAR;
            PG8_LDB(B0, 1, 0); PG8_SCHED; PG8_LDA(At, 1, 0); PG8_STAGE(PG8_SA(0, 1), a2 + hstep, voffA);
            PG8_WAIT_L(8); PG8_BAR; PG8_WAIT_L(0); PG8_MMA(0, 0, At, B0); PG8_BAR; PG8_SCHED;
            PG8_LDB(B1, 1, 1); PG8_STAGE(PG8_SB(1, 0), b3, voffB);
            PG8_BAR; PG8_WAIT_L(0); PG8_MMA(0, 1, At, B1); PG8_BAR;
            PG8_LDA(At, 1, 1); PG8_STAGE(PG8_SA(1, 0), a3, voffA);
            PG8_BAR; PG8_WAIT_L(0); PG8_MMA(1, 0, At, B0); PG8_BAR; PG8_SCHED;
            PG8_STAGE(PG8_SB(1, 1), b3 + hstep, voffB);
            PG8_WAIT_V(6); PG8_BAR; PG8_MMA(1, 1, At, B1); PG8_BAR;
            }
        }
        if constexpr (ALIGN_EPI) { if (wr == 0) PG8_BAR; }
        E(acc, cur, wr, wc, fr, fq);
        if (!has_next) break;
#pragma unroll
        for (int a = 0; a < 2; ++a)
#pragma unroll
            for (int b = 0; b < 2; ++b)
#pragma unroll
                for (int m = 0; m < 4; ++m)
#pragma unroll
                    for (int n = 0; n < 2; ++n) acc[a][b][m][n] = (f32x4){0.f, 0.f, 0.f, 0.f};
        cur = nxt; cA = nA; cB = nB; ++ui;
        if constexpr (ALIGN_EPI) { if (wr == 1) PG8_BAR; }
    }
    PG8_WAIT_V(0);
    if constexpr (!ALIGN_EPI) { if (wr == 0) PG8_BAR; }
    PG8_BAR;
#undef PG8_SA
#undef PG8_SB
#undef PG8_STAGE
#undef PG8_LDA
#undef PG8_LDB
#undef PG8_MMA
#undef PG8_WAIT_V
#undef PG8_WAIT_L
#undef PG8_BAR
#undef PG8_SCHED
}
}
using pg8::Unit;
typedef f32x4 AccT[2][2][4][2];

DI u32x4 pack8(f32x4 v0, f32x4 v1) { u32x4 w; w.x = cvt_pk_bf16(v0[0], v0[1]); w.y = cvt_pk_bf16(v0[2], v0[3]); w.z = cvt_pk_bf16(v1[0], v1[1]); w.w = cvt_pk_bf16(v1[2], v1[3]); return w; }
struct EpiPlain {
    static constexpr bool PERM = true;
    u16* buf6; const float* bias;
    DI void operator()(const AccT& acc, const Unit& u, int wr, int wc, int fr, int fq) const {
        const int row0 = u.pm * 256 + wr * 64 + fr, bcol0 = u.pn * 256 + wc * 32 + 8 * fq;
        f32x4 bv[2][2];
#pragma unroll
        for (int bj = 0; bj < 2; ++bj)
#pragma unroll
            for (int n = 0; n < 2; ++n) bv[bj][n] = *(const f32x4*)(bias + bcol0 + bj * 128 + 4 * n);
        u16* base = buf6 + (size_t)(u.pn >> 2) * TS; const int col0 = (u.pn & 3) * 256 + wc * 32 + 8 * fq;
#pragma unroll
        for (int ai = 0; ai < 2; ++ai)
#pragma unroll
            for (int m = 0; m < 4; ++m) { u16* rowp = base + (size_t)(row0 + ai * 128 + m * 16) * DM + col0;
#pragma unroll
                for (int bj = 0; bj < 2; ++bj) *(u32x4*)(rowp + bj * 128) = pack8(acc[ai][bj][m][0] + bv[bj][0], acc[ai][bj][m][1] + bv[bj][1]); }
    }
};
struct EpiGateM {
    static constexpr bool PERM = true;
    u16* gate_m; const float* bias;
    DI void operator()(const AccT& acc, const Unit& u, int wr, int wc, int fr, int fq) const {
        const int row0 = u.pm * 256 + wr * 64 + fr, bcol0 = u.pn * 256 + wc * 32 + 8 * fq;
        f32x4 bv[2][2];
#pragma unroll
        for (int bj = 0; bj < 2; ++bj)
#pragma unroll
            for (int n = 0; n < 2; ++n) bv[bj][n] = *(const f32x4*)(bias + bcol0 + bj * 128 + 4 * n);
        const int col0 = u.pn * 128 + wc * 32 + 8 * fq;
#pragma unroll
        for (int ai = 0; ai < 2; ++ai)
#pragma unroll
            for (int m = 0; m < 4; ++m) { u16* rowp = gate_m + (size_t)(row0 + ai * 128 + m * 16) * DM + col0;
                f32x4 r[2];
#pragma unroll
                for (int n = 0; n < 2; ++n) { const f32x4 o = acc[ai][0][m][n] + bv[0][n], z = acc[ai][1][m][n] + bv[1][n];
#pragma unroll
                    for (int j = 0; j < 4; ++j) r[n][j] = z[j] * __builtin_amdgcn_rcpf((1.0f + __expf(-o[j])) * (1.0f + __expf(-z[j]))); }
                *(u32x4*)rowp = pack8(r[0], r[1]); }
    }
};
template <int ACT> struct EpiAct {
    static constexpr bool PERM = true;
    u16* out2; const float* bias;
    DI void operator()(const AccT& acc, const Unit& u, int wr, int wc, int fr, int fq) const {
        const int row0 = u.pm * 256 + wr * 64 + fr, bcol0 = u.pn * 256 + wc * 32 + 8 * fq;
        u16* base = out2 + (size_t)(u.pn >> 2) * TS; const int col0 = (u.pn & 3) * 256 + wc * 32 + 8 * fq;
        f32x4 bv[2][2];
#pragma unroll
        for (int bj = 0; bj < 2; ++bj)
#pragma unroll
            for (int n = 0; n < 2; ++n) bv[bj][n] = *(const f32x4*)(bias + bcol0 + bj * 128 + 4 * n);
#pragma unroll
        for (int ai = 0; ai < 2; ++ai)
#pragma unroll
            for (int m = 0; m < 4; ++m) { u16* rowp = base + (size_t)(row0 + ai * 128 + m * 16) * DM + col0;
#pragma unroll
                for (int bj = 0; bj < 2; ++bj) { f32x4 r[2];
#pragma unroll
                    for (int n = 0; n < 2; ++n) { const f32x4 z = acc[ai][bj][m][n] + bv[bj][n];
#pragma unroll
                        for (int j = 0; j < 4; ++j) r[n][j] = ACT ? sigmoidf_(z[j]) : siluf_(z[j]); }
                    *(u32x4*)(rowp + bj * 128) = pack8(r[0], r[1]); } }
    }
};
template <bool SECOND> struct EpiMerge {
    static constexpr bool PERM = true;
    const u16* g; u16* t1; u16* merged;
    DI void operator()(const AccT& acc, const Unit& u, int wr, int wc, int fr, int fq) const {
        const int row0 = u.pm * 256 + wr * 64 + fr, col0 = u.pn * 256 + wc * 32 + 8 * fq;
#pragma unroll
        for (int ai = 0; ai < 2; ++ai) {
            u32x4 gw[4][2], tw[4][2];
#pragma unroll
            for (int m = 0; m < 4; ++m)
#pragma unroll
                for (int bj = 0; bj < 2; ++bj) { const size_t o = (size_t)(row0 + ai * 128 + m * 16) * DM + col0 + bj * 128;
                    gw[m][bj] = *(const u32x4*)(g + o); if (SECOND) tw[m][bj] = *(const u32x4*)(t1 + o); }
#pragma unroll
            for (int m = 0; m < 4; ++m)
#pragma unroll
                for (int bj = 0; bj < 2; ++bj) { const size_t o = (size_t)(row0 + ai * 128 + m * 16) * DM + col0 + bj * 128;
                    const u32x4 gq = gw[m][bj];
                    f32x4 g0 = (f32x4){bflo(gq.x), bfhi(gq.x), bflo(gq.y), bfhi(gq.y)}, g1 = (f32x4){bflo(gq.z), bfhi(gq.z), bflo(gq.w), bfhi(gq.w)};
                    f32x4 v0 = g0 * acc[ai][bj][m][0], v1 = g1 * acc[ai][bj][m][1];
                    if (!SECOND) { *(u32x4*)(t1 + o) = pack8(v0, v1); }
                    else { const u32x4 tq = tw[m][bj];
                        v0 += (f32x4){bflo(tq.x), bfhi(tq.x), bflo(tq.y), bfhi(tq.y)}; v1 += (f32x4){bflo(tq.z), bfhi(tq.z), bflo(tq.w), bfhi(tq.w)};
                        *(u32x4*)(merged + o) = pack8(v0, v1); } }
        }
    }
};
struct EpiOut {
    static constexpr bool PERM = false;
    const float* x; float* out;
    DI void operator()(const AccT& acc, const Unit& u, int wr, int wc, int fr, int fq) const {
        const int row0 = u.pm * 256 + wr * 64 + fr, col0 = u.pn * 256 + wc * 32 + 4 * fq;
#pragma unroll
        for (int ai = 0; ai < 2; ++ai) {
            f32x4 xv[4][2][2];
#pragma unroll
            for (int m = 0; m < 4; ++m)
#pragma unroll
                for (int bj = 0; bj < 2; ++bj)
#pragma unroll
                    for (int n = 0; n < 2; ++n) xv[m][bj][n] = *(const f32x4*)(x + (size_t)(row0 + ai * 128 + m * 16) * DM + col0 + bj * 128 + n * 16);
#pragma unroll
            for (int m = 0; m < 4; ++m)
#pragma unroll
                for (int bj = 0; bj < 2; ++bj)
#pragma unroll
                    for (int n = 0; n < 2; ++n) *(f32x4*)(out + (size_t)(row0 + ai * 128 + m * 16) * DM + col0 + bj * 128 + n * 16) = xv[m][bj][n] + acc[ai][bj][m][n];
        }
    }
};

struct Args {
    const float* x; const float* norm_w; const float* w_in; const float* b_in; const float* conv_w; const float* conv_b; const float* mnorm_w;
    const float* qn_w; const float* kn_w; const float* w_pm; const float* w_ps; const float* w_out;
    float* out; unsigned char* ws; int ph_lo, ph_hi;
};

__host__ __device__ __forceinline__ int src_col_of(int r0) {
    if (r0 < 3072) return r0;
    if (r0 < 6144) return C_SQ + (r0 - 3072);
    if (r0 < 8192) { const int q = r0 - 6144, j = q >> 8, w = q & 255; return w < 128 ? C_MO + 128 * j + w : C_MZ + 128 * j + (w - 128); }
    if (r0 < 9216) return C_SZ + (r0 - 8192);
    return C_G + (r0 - 9216);
}
DI void p0_transpose_item(const float* W, int ldw, int src0, u16* WT, int dst0, int k0, LAS float* scr, int lane) {
    float tv[32];
#pragma unroll
    for (int i = 0; i < 32; ++i) tv[i] = W[(size_t)(k0 + 2 * i + (lane >> 5)) * ldw + src0 + (lane & 31)];
#pragma unroll
    for (int i = 0; i < 32; ++i) scr[(2 * i + (lane >> 5)) * 33 + (lane & 31)] = tv[i];
    LDS_FENCE();
    const int c = lane & 7;
#pragma unroll
    for (int j = 0; j < 4; ++j) { const int n = (lane >> 3) + 8 * j; const LAS float* s = scr + (8 * c) * 33 + n;
        u32x4 o; o.x = cvt_pk_bf16(s[0 * 33], s[1 * 33]); o.y = cvt_pk_bf16(s[2 * 33], s[3 * 33]); o.z = cvt_pk_bf16(s[4 * 33], s[5 * 33]); o.w = cvt_pk_bf16(s[6 * 33], s[7 * 33]);
        *(u32x4*)(WT + (size_t)(dst0 + n) * DM + k0 + 8 * c) = o; }
    LDS_FENCE();
}
DI void p0_prologue(const Args& a, LAS unsigned char* lds, int tid, int lane, int wave) {
    unsigned char* ws = a.ws;
    u16* WALL = (u16*)(ws + WS_WALL); float* BIAS = (float*)(ws + WS_BIAS); float* IGF = (float*)(ws + WS_IGF); u16* HB = (u16*)(ws + WS_H);
    const int G = gridDim.x, gw = blockIdx.x * 8 + wave, NGW = G * 8;
    LAS float* scr = (LAS float*)(lds + wave * 8448);
    LAS float* W8 = (LAS float*)(lds + 8 * 8448);
    for (int i = tid; i < 8 * 1024; i += 512) { const int c = i >> 10, k = i & 1023; W8[i] = a.w_in[(size_t)k * IN_COLS + C_MI + c]; }
    constexpr int I_ALL = (NALL / 32) * 16, I_P = 32 * 16, NITEMS = I_ALL + 3 * I_P;
    for (int it = gw; it < NITEMS; it += NGW) {
        if (it < I_ALL) { const int db = it >> 4, kb = it & 15; p0_transpose_item(a.w_in, IN_COLS, src_col_of(db * 32), WALL, db * 32, kb * 64, scr, lane); }
        else { int r = it - I_ALL; const int which = r / I_P; r -= which * I_P; const int db = r >> 4, kb = r & 15;
            const float* W = which == 0 ? a.w_pm : (which == 1 ? a.w_ps : a.w_out); u16* WT = (u16*)(ws + (which == 0 ? WS_WPM : (which == 1 ? WS_WPS : WS_WOUT)));
            p0_transpose_item(W, DM, db * 32, WT, db * 32, kb * 64, scr, lane); }
    }
    for (int i = blockIdx.x * 512 + tid; i < NALL; i += G * 512) BIAS[i] = a.b_in[src_col_of(i)];
    __syncthreads();
    f32x4 nw[4];
#pragma unroll
    for (int j = 0; j < 4; ++j) nw[j] = *(const f32x4*)(a.norm_w + 256 * j + 4 * lane);
    const float bg = lane < 8 ? a.b_in[C_MI + lane] : 0.f;
    for (int m0 = gw * 4; m0 < MT; m0 += NGW * 4) {
        f32x4 v[4][4]; float rstd[4];
#pragma unroll
        for (int r = 0; r < 4; ++r) { const f32x4* xr = (const f32x4*)(a.x + (size_t)(m0 + r) * DM) + lane;
#pragma unroll
            for (int j = 0; j < 4; ++j) v[r][j] = xr[64 * j]; }
#pragma unroll
        for (int r = 0; r < 4; ++r) { float s2 = 0.f;
#pragma unroll
            for (int j = 0; j < 4; ++j) s2 += (v[r][j].x * v[r][j].x + v[r][j].y * v[r][j].y) + (v[r][j].z * v[r][j].z + v[r][j].w * v[r][j].w);
            rstd[r] = 1.0f / sqrtf(wave_sum(s2) * (1.f / DM) + EPS); }
#pragma unroll
        for (int r = 0; r < 4; ++r) {
#pragma unroll
            for (int j = 0; j < 4; ++j) v[r][j] = v[r][j] * rstd[r] * nw[j];
            unsigned long long* o8 = (unsigned long long*)(HB + (size_t)(m0 + r) * DM) + lane;
#pragma unroll
            for (int j = 0; j < 4; ++j) o8[64 * j] = (unsigned long long)cvt_pk_bf16(v[r][j].x, v[r][j].y) | ((unsigned long long)cvt_pk_bf16(v[r][j].z, v[r][j].w) << 32);
        }
        float d8[4][8];
#pragma unroll
        for (int c = 0; c < 8; ++c) { f32x4 w[4];
#pragma unroll
            for (int j = 0; j < 4; ++j) w[j] = *(const LAS f32x4*)(W8 + c * 1024 + 256 * j + 4 * lane);
#pragma unroll
            for (int r = 0; r < 4; ++r) { float d = 0.f;
#pragma unroll
                for (int j = 0; j < 4; ++j) d += (v[r][j].x * w[j].x + v[r][j].y * w[j].y) + (v[r][j].z * w[j].z + v[r][j].w * w[j].w);
                d8[r][c] = d; } }
#pragma unroll
        for (int r = 0; r < 4; ++r) {
            float d4[4], d2[2], d1;
            { const bool up = lane & 1;
#pragma unroll
              for (int i = 0; i < 4; ++i) { const float keep = up ? d8[r][2 * i + 1] : d8[r][2 * i], give = up ? d8[r][2 * i] : d8[r][2 * i + 1]; d4[i] = keep + __shfl_xor(give, 1); } }
            { const bool up = lane & 2;
#pragma unroll
              for (int i = 0; i < 2; ++i) { const float keep = up ? d4[2 * i + 1] : d4[2 * i], give = up ? d4[2 * i] : d4[2 * i + 1]; d2[i] = keep + __shfl_xor(give, 2); } }
            { const bool up = lane & 4; const float keep = up ? d2[1] : d2[0], give = up ? d2[0] : d2[1]; d1 = keep + __shfl_xor(give, 4); }
            d1 += __shfl_xor(d1, 8); d1 += __shfl_xor(d1, 16); d1 += __shfl_xor(d1, 32);
            if (lane < 8) { float p = d1 + bg; if (lane >= 4) p = fminf(p, 0.f) - log1pf(expf(-fabsf(p))); IGF[(size_t)(m0 + r) * 8 + lane] = p; }
        }
    }
    __syncthreads();
}

constexpr int ML_LDQ = 264, ML_LDV = 88, ML_LDP = 72, ML_LDH = 68;
constexpr int ML_QS = 0, ML_KS = 33792, ML_VS = 67584, ML_PS = 78848, ML_CS = 88064, ML_VEC = 130304, ML_CW = 131904;
static_assert(ML_CW + 10240 <= LDS_BYTES, "mLSTM LDS map");
DI void mlstm_item(const Args& a, LAS unsigned char* lds, int item, int tid, int wave) {
    unsigned char* ws = a.ws;
    const u16* MQ = (const u16*)(ws + WS_B6); const u16* MK = MQ + TS; u16* MV = (u16*)(ws + WS_B6) + 2 * TS;
    const float* IGF = (const float*)(ws + WS_IGF); float* SSQ = (float*)(ws + WS_SSQ); const u16* GM = (const u16*)a.out;
    const int es = item & 3, h = (item >> 2) & 3, b = item >> 4;
    LAS u16* QS = (LAS u16*)(lds + ML_QS); LAS u16* KS = (LAS u16*)(lds + ML_KS); LAS u16* VS = (LAS u16*)(lds + ML_VS); LAS u16* PS = (LAS u16*)(lds + ML_PS); LAS u16* CS = (LAS u16*)(lds + ML_CS);
    LAS float* HS = (LAS float*)(lds + ML_QS);
    LAS float* bcum = (LAS float*)(lds + ML_VEC); LAS float* avec = bcum + 64; LAS float* mtv = bcum + 128; LAS float* wint = bcum + 192; LAS float* wsv = bcum + 256; LAS float* denv = bcum + 320; LAS float* misc = bcum + 384;
    LAS float* CW = (LAS float*)(lds + ML_CW);
    __syncthreads();
    for (int i = tid; i < 2560; i += 512) { const int kq = i >= 1280, r = i - kq * 1280; const int ch = kq * 1024 + h * 256 + (r & 255);
        CW[i] = r < 1024 ? a.conv_w[(size_t)(r >> 8) * 2048 + ch] : a.conv_b[ch]; }
    for (int i = tid; i < 80 * ML_LDQ / 2; i += 512) ((LAS unsigned*)CS)[i] = 0u;
    f32x4 accC[5][2];
#pragma unroll
    for (int et = 0; et < 5; ++et)
#pragma unroll
        for (int dt = 0; dt < 2; ++dt) accC[et][dt] = (f32x4){0.f, 0.f, 0.f, 0.f};
    float m_prev = 0.f;
    u32x4 rq[7], rk[7], vnext, gnext; float ign = 0.f, lfn = 0.f;
#define ML_LOAD_CHUNK(cc) do { \
        int tl_ = tid; asm volatile("" : "+v"(tl_)); \
        const int dg_ = tl_ & 31, seg_ = tl_ >> 5, orow_ = tl_ >> 3, opiece_ = tl_ & 7; \
        const u16* sq_ = MQ + h * 256 + dg_ * 8; const u16* sk_ = MK + h * 256 + dg_ * 8; \
        _Pragma("unroll") for (int jj = 0; jj < 7; ++jj) { const int sp = (cc) * 64 + 4 * seg_ - 3 + jj; \
            rq[jj] = sp >= 0 ? *(const u32x4*)(sq_ + ((size_t)b * SEQ + sp) * DM) : (u32x4){0u, 0u, 0u, 0u}; \
            rk[jj] = sp >= 0 ? *(const u32x4*)(sk_ + ((size_t)b * SEQ + sp) * DM) : (u32x4){0u, 0u, 0u, 0u}; } \
        vnext = *(const u32x4*)(MV + ((size_t)b * SEQ + (size_t)(cc) * 64 + orow_) * DM + h * 256 + es * 64 + opiece_ * 8); \
        gnext = *(const u32x4*)(GM + ((size_t)b * SEQ + (size_t)(cc) * 64 + orow_) * DM + h * 256 + es * 64 + opiece_ * 8); \
        if (wave == 0) { const size_t tg_ = ((size_t)b * SEQ + (size_t)(cc) * 64 + (tl_ & 63)) * 8; ign = IGF[tg_ + h]; lfn = IGF[tg_ + 4 + h]; } \
    } while (0)
    ML_LOAD_CHUNK(0);
    float nwv[8];
    { const int op_ = tid & 7;
#pragma unroll
      for (int j = 0; j < 8; ++j) nwv[j] = a.mnorm_w[h * 256 + es * 64 + op_ * 8 + j]; }
    __syncthreads();
    for (int c = 0; c < 64; ++c) {
        const size_t tokc = (size_t)b * SEQ + (size_t)c * 64;
        int tl = tid; asm volatile("" : "+v"(tl));
        const int lane = tl & 63, g = lane >> 4, c16 = lane & 15;
        const int orow = tl >> 3, opiece = tl & 7;
        const int dg = tl & 31, seg = tl >> 5;
#pragma unroll
        for (int kq = 0; kq < 2; ++kq) {
            const LAS float* cw = CW + kq * 1280 + dg * 8;
            f32x4 wt[4][2], bb[2];
#pragma unroll
            for (int j = 0; j < 4; ++j) { wt[j][0] = *(const LAS f32x4*)(cw + j * 256); wt[j][1] = *(const LAS f32x4*)(cw + j * 256 + 4); }
            bb[0] = *(const LAS f32x4*)(cw + 1024); bb[1] = *(const LAS f32x4*)(cw + 1028);
#pragma unroll
            for (int rr = 0; rr < 4; ++rr) {
                f32x4 s0 = bb[0], s1 = bb[1];
#pragma unroll
                for (int j = 0; j < 4; ++j) { const u32x4 w = kq ? rk[rr + j] : rq[rr + j];
                    s0 += wt[j][0] * (f32x4){bflo(w.x), bfhi(w.x), bflo(w.y), bfhi(w.y)}; s1 += wt[j][1] * (f32x4){bflo(w.z), bfhi(w.z), bflo(w.w), bfhi(w.w)}; }
#pragma unroll
                for (int j = 0; j < 4; ++j) { s0[j] = siluf_(s0[j]); s1[j] = siluf_(s1[j]); }
                *(LAS u32x4*)((kq ? KS : QS) + (4 * seg + rr) * ML_LDQ + dg * 8) = pack8(s0, s1);
            }
        }
        const u32x4 vreg = vnext, gw = gnext;
        *(LAS u32x4*)(VS + orow * ML_LDV + opiece * 8) = vreg;
        if (opiece == 0) { *(LAS u32x4*)(VS + orow * ML_LDV + 64) = (u32x4){0x3F80u, 0u, 0u, 0u}; *(LAS u32x4*)(VS + orow * ML_LDV + 72) = (u32x4){0u, 0u, 0u, 0u}; }
        if (wave == 0) {
            const float ig = ign, lf = lfn;
            float bc = lf;
#pragma unroll
            for (int o = 1; o < 64; o <<= 1) { const float t = __shfl_up(bc, o); if (lane >= o) bc += t; }
            const float av = ig - bc; float pm = av;
#pragma unroll
            for (int o = 1; o < 64; o <<= 1) { const float t = __shfl_up(pm, o); if (lane >= o) pm = fmaxf(pm, t); }
            const float inter = bc + m_prev, mt = fmaxf(inter, bc + pm);
            const float blast = __shfl(bc, 63), dec = blast + av;
            const float mnew = fmaxf(blast + m_prev, wave_max(dec));
            bcum[lane] = bc; avec[lane] = av; mtv[lane] = mt; wint[lane] = expf(inter - mt); wsv[lane] = expf(dec - mnew);
            if (lane == 0) misc[0] = expf(blast + m_prev - mnew);
            m_prev = mnew;
        }
        if (c + 1 < 64) ML_LOAD_CHUNK(c + 1);
        __syncthreads();
        {
            const int tt = wave >> 1;
#pragma unroll
            for (int si = 0; si < 2; ++si) { const int st = (wave & 1) * 2 + si;
                f32x4 s = (f32x4){0.f, 0.f, 0.f, 0.f};
                if (st <= tt) {
                    __builtin_amdgcn_s_setprio(1);
#pragma unroll
                    for (int ks = 0; ks < 8; ++ks) s = MFMA16(row_frag(KS, ML_LDQ, 16 * st + c16, 32 * ks + 8 * g), row_frag(QS, ML_LDQ, 16 * tt + c16, 32 * ks + 8 * g), s);
                    __builtin_amdgcn_s_setprio(0);
                }
                const int t = 16 * tt + c16, s0 = 16 * st + 4 * g; const float bt_ = bcum[t] - mtv[t]; const f32x4 as = *(const LAS f32x4*)(avec + s0);
                f32x4 v;
#pragma unroll
                for (int i = 0; i < 4; ++i) v[i] = (s0 + i) <= t ? s[i] * (0.0625f * __expf(bt_ + as[i])) : 0.f;
                u32x2 w; w.x = cvt_pk_bf16(v[0], v[1]); w.y = cvt_pk_bf16(v[2], v[3]);
                *(LAS u32x2*)(PS + t * ML_LDP + s0) = w; }
        }
        __syncthreads();
        const int tt = wave & 3, et0 = wave < 4 ? 0 : 3, net = wave < 4 ? 3 : 2;
        const int tq = 16 * tt + c16;
        f32x4 num[3];
        { const float wi = wint[tq];
#pragma unroll
        for (int ei = 0; ei < 3; ++ei) {
            num[ei] = (f32x4){0.f, 0.f, 0.f, 0.f};
            if (ei < net) { const int et = et0 + ei;
                f32x4 a1 = (f32x4){0.f, 0.f, 0.f, 0.f}, a2 = (f32x4){0.f, 0.f, 0.f, 0.f};
                __builtin_amdgcn_s_setprio(1);
#pragma unroll
                for (int ks = 0; ks < 2; ++ks) a1 = MFMA16(tr_frag(VS, ML_LDV, 32 * ks, 16 * et, lane), row_frag(PS, ML_LDP, 16 * tt + c16, 32 * ks + 8 * g), a1);
#pragma unroll
                for (int ks = 0; ks < 8; ++ks) a2 = MFMA16(row_frag(CS, ML_LDQ, 16 * et + c16, 32 * ks + 8 * g), row_frag(QS, ML_LDQ, 16 * tt + c16, 32 * ks + 8 * g), a2);
                __builtin_amdgcn_s_setprio(0);
                num[ei] = a1 + a2 * wi;
                if (et == 4 && g == 0) denv[tq] = num[ei][0];
            }
        } }
        __syncthreads();
        { const float rden = __builtin_amdgcn_rcpf(fmaxf(fabsf(denv[tq]), __expf(-mtv[tq])));
#pragma unroll
          for (int ei = 0; ei < 3; ++ei) if (ei < net && et0 + ei < 4) *(LAS f32x4*)(HS + tq * ML_LDH + 16 * (et0 + ei) + 4 * g) = num[ei] * rden; }
        {
            const float w = wsv[orow] * 0.0625f;
            f32x4 v0 = (f32x4){bflo(vreg.x), bfhi(vreg.x), bflo(vreg.y), bfhi(vreg.y)} * w, v1 = (f32x4){bflo(vreg.z), bfhi(vreg.z), bflo(vreg.w), bfhi(vreg.w)} * w;
            *(LAS u32x4*)(VS + orow * ML_LDV + opiece * 8) = pack8(v0, v1);
            if (opiece == 0) VS[orow * ML_LDV + 64] = f2bf(w);
        }
        __syncthreads();
        {
            const f32x4 h0 = *(const LAS f32x4*)(HS + orow * ML_LDH + opiece * 8), h1 = *(const LAS f32x4*)(HS + orow * ML_LDH + opiece * 8 + 4);
            float ss = (h0.x * h0.x + h0.y * h0.y) + (h0.z * h0.z + h0.w * h0.w) + (h1.x * h1.x + h1.y * h1.y) + (h1.z * h1.z + h1.w * h1.w);
            ss += __shfl_xor(ss, 1); ss += __shfl_xor(ss, 2); ss += __shfl_xor(ss, 4);
            if (opiece == 0) SSQ[(tokc + orow) * 16 + h * 4 + es] = ss;
            const size_t go = (tokc + orow) * DM + h * 256 + es * 64 + opiece * 8;
            f32x4 y0, y1;
            y0[0] = h0.x * nwv[0] * bflo(gw.x); y0[1] = h0.y * nwv[1] * bfhi(gw.x); y0[2] = h0.z * nwv[2] * bflo(gw.y); y0[3] = h0.w * nwv[3] * bfhi(gw.y);
            y1[0] = h1.x * nwv[4] * bflo(gw.z); y1[1] = h1.y * nwv[5] * bfhi(gw.z); y1[2] = h1.z * nwv[6] * bflo(gw.w); y1[3] = h1.w * nwv[7] * bfhi(gw.w);
            *(u32x4*)(MV + go) = pack8(y0, y1);
        }
        {
            const float cs = misc[0];
#pragma unroll
            for (int et = 0; et < 5; ++et)
#pragma unroll
                for (int dt = 0; dt < 2; ++dt) accC[et][dt] = accC[et][dt] * cs;
            __builtin_amdgcn_s_setprio(1);
#pragma unroll
            for (int ks = 0; ks < 2; ++ks) {
                bf16x8 kb[2];
#pragma unroll
                for (int dt = 0; dt < 2; ++dt) kb[dt] = tr_frag(KS, ML_LDQ, 32 * ks, 32 * wave + 16 * dt, lane);
#pragma unroll
                for (int et = 0; et < 5; ++et) { const bf16x8 va = tr_frag(VS, ML_LDV, 32 * ks, 16 * et, lane);
#pragma unroll
                    for (int dt = 0; dt < 2; ++dt) accC[et][dt] = MFMA16(kb[dt], va, accC[et][dt]); }
            }
            __builtin_amdgcn_s_setprio(0);
#pragma unroll
            for (int et = 0; et < 5; ++et)
#pragma unroll
                for (int dt = 0; dt < 2; ++dt)
                    { u32x2 w; w.x = cvt_pk_bf16(accC[et][dt][0], accC[et][dt][1]); w.y = cvt_pk_bf16(accC[et][dt][2], accC[et][dt][3]);
                      *(LAS u32x2*)(CS + (16 * et + c16) * ML_LDQ + 32 * wave + 16 * dt + 4 * g) = w; }
        }
        __syncthreads();
    }
#undef ML_LOAD_CHUNK
}

constexpr float SB_CUT = 20.0f;
constexpr int AT_LD = 136, AT_LDL = 40, AT_WSZ = 12288;
static_assert(8 * AT_WSZ <= LDS_BYTES && 32 * AT_LD * 2 + 2 * 16 * AT_LDL * 2 <= AT_WSZ, "attention LDS map");
DI void attn_phase(const Args& a, LAS unsigned char* lds, int lane, int wave) {
    unsigned char* ws = a.ws;
    u16* SQ = (u16*)(ws + WS_B6) + 3 * TS; const u16* SK = SQ + TS; const u16* SV = SQ + 2 * TS; const u16* GS = (const u16*)a.out + TS;
    constexpr int NWI = NB * 8 * 256;
    const int NW = gridDim.x * 8;
    const int g = lane >> 4, c16 = lane & 15;
    LAS u16* VA = (LAS u16*)(lds + wave * AT_WSZ); LAS u16* L1H = VA + 32 * AT_LD; LAS u16* L1L = L1H + 16 * AT_LDL; LAS u16* PW = L1H;
    const int orow = lane >> 2, opart = lane & 3;
    const int vrow = lane >> 4, vpc = lane & 15;
    u32x4 qr[4], kr[2][4], vr[8];
#define AT_LOAD_V(bb, hh, kbb) do { _Pragma("unroll") for (int p = 0; p < 8; ++p) vr[p] = *(const u32x4*)(SV + ((size_t)(bb) * SEQ + (size_t)(kbb) * 32 + 4 * p + vrow) * DM + (hh) * 128 + 8 * vpc); } while (0)
#define AT_LOAD_Q(bb, hh, rtt) do { const size_t t_ = (size_t)(bb) * SEQ + (size_t)(rtt) * 16; \
        _Pragma("unroll") for (int ks = 0; ks < 4; ++ks) qr[ks] = *(const u32x4*)(SQ + (t_ + c16) * DM + (hh) * 128 + 32 * ks + 8 * g); } while (0)
#define AT_LOAD_K(bb, hh, kbb) do { const size_t t_ = (size_t)(bb) * SEQ + (size_t)(kbb) * 32; \
        _Pragma("unroll") for (int st = 0; st < 2; ++st) _Pragma("unroll") for (int ks = 0; ks < 4; ++ks) kr[st][ks] = *(const u32x4*)(SK + (t_ + 16 * st + c16) * DM + (hh) * 128 + 32 * ks + 8 * g); } while (0)
    { const int wi0 = blockIdx.x * 8 + wave; if (wi0 < NWI) { const int rt0 = wi0 & 255, h0 = (wi0 >> 8) & 7, b0 = wi0 >> 11; AT_LOAD_Q(b0, h0, rt0); AT_LOAD_K(b0, h0, rt0 >> 1); AT_LOAD_V(b0, h0, rt0 >> 1); } }
    for (int wi = blockIdx.x * 8 + wave; wi < NWI; wi += NW) {
        const int rt = wi & 255, h = (wi >> 8) & 7, b = wi >> 11;
        const size_t tok0 = (size_t)b * SEQ + (size_t)rt * 16;
        const int kb0 = rt >> 1;
        bf16x8 qf[4];
        {
            float ss = 0.f;
#pragma unroll
            for (int ks = 0; ks < 4; ++ks) ss = sumsq8(qr[ks], ss);
            ss += __shfl_xor(ss, 16); ss += __shfl_xor(ss, 32);
            const float rs = 1.0f / sqrtf(ss * (1.f / 128.f) + EPS);
#pragma unroll
            for (int ks = 0; ks < 4; ++ks) {
                const int d0 = 32 * ks + 8 * g;
                const f32x4 w0 = *(const f32x4*)(a.qn_w + d0) * *(const f32x4*)(a.kn_w + d0) * 0.08838834764831845f, w1 = *(const f32x4*)(a.qn_w + d0 + 4) * *(const f32x4*)(a.kn_w + d0 + 4) * 0.08838834764831845f;
                const f32x4 v0 = (f32x4){bflo(qr[ks].x), bfhi(qr[ks].x), bflo(qr[ks].y), bfhi(qr[ks].y)} * w0 * rs, v1 = (f32x4){bflo(qr[ks].z), bfhi(qr[ks].z), bflo(qr[ks].w), bfhi(qr[ks].w)} * w1 * rs;
                const u32x4 pk = pack8(v0, v1); qf[ks] = __builtin_bit_cast(bf16x8, pk); }
        }
        f32x4 oacc[8];
#pragma unroll
        for (int et = 0; et < 8; ++et) oacc[et] = (f32x4){0.f, 0.f, 0.f, 0.f};
        float carry[4] = {0.f, 0.f, 0.f, 0.f};
        for (int kb = kb0; kb >= 0; --kb) {
            bf16x8 kf[2][4]; float rk[2];
#pragma unroll
            for (int st = 0; st < 2; ++st) { float ss = 0.f;
#pragma unroll
                for (int ks = 0; ks < 4; ++ks) { const u32x4 w = kr[st][ks]; kf[st][ks] = __builtin_bit_cast(bf16x8, w); ss = sumsq8(w, ss); }
                ss += __shfl_xor(ss, 16); ss += __shfl_xor(ss, 32);
                rk[st] = 1.0f / sqrtf(ss * (1.f / 128.f) + EPS); }
            if (kb != kb0) AT_LOAD_V(b, h, kb);
            if (kb > 0) AT_LOAD_K(b, h, kb - 1);
            f32x4 lb[2], l1v[2];
#pragma unroll
            for (int st = 0; st < 2; ++st) {
                f32x4 z = (f32x4){0.f, 0.f, 0.f, 0.f};
                __builtin_amdgcn_s_setprio(1);
#pragma unroll
                for (int ks = 0; ks < 4; ++ks) z = MFMA16(qf[ks], kf[st][ks], z);
                __builtin_amdgcn_s_setprio(0);
                const int sg = kb * 32 + 16 * st + c16;
#pragma unroll
                for (int i = 0; i < 4; ++i) { const int tg = rt * 16 + 4 * g + i;
                    const float zz = z[i] * rk[st];
                    const float sp = softplus_fast(zz);
                    lb[st][i] = zz - sp; l1v[st][i] = sg < tg ? -sp : 0.f; }
            }
            float tot[4];
#pragma unroll
            for (int i = 0; i < 4; ++i) {
                const float t1 = row16_sum(l1v[1][i]), t0 = row16_sum(l1v[0][i]);
                const float b0 = row16_suffix(l1v[0][i]) - l1v[0][i] + t1, b1 = row16_suffix(l1v[1][i]) - l1v[1][i];
                tot[i] = t0 + t1;
                const int tg = rt * 16 + 4 * g + i;
                const float a0 = (kb * 32 + c16) < tg ? __expf(lb[0][i] + b0 + carry[i]) : 0.f, a1 = (kb * 32 + 16 + c16) < tg ? __expf(lb[1][i] + b1 + carry[i]) : 0.f;
                PW[(4 * g + i) * AT_LDL + c16] = f2bf(a0); PW[(4 * g + i) * AT_LDL + 16 + c16] = f2bf(a1);
            }
#pragma unroll
            for (int i = 0; i < 4; ++i) carry[i] += tot[i];
#pragma unroll
            for (int p = 0; p < 8; ++p) *(LAS u32x4*)(VA + (4 * p + vrow) * AT_LD + 8 * vpc) = vr[p];
            LDS_FENCE();
            { const bf16x8 pa = row_frag(PW, AT_LDL, c16, 8 * g);
              __builtin_amdgcn_s_setprio(1);
#pragma unroll
              for (int et = 0; et < 8; ++et) oacc[et] = MFMA16(pa, tr_frag(VA, AT_LD, 0, 16 * et, lane), oacc[et]);
              __builtin_amdgcn_s_setprio(0); }
            const float wm = fmaxf(fmaxf(carry[0], carry[1]), fmaxf(carry[2], carry[3]));
            if (__builtin_amdgcn_ballot_w64(wm >= -SB_CUT) == 0ull) break;
        }
        const size_t go = (tok0 + orow) * DM + h * 128 + opart * 32;
        u32x4 gsr[4];
#pragma unroll
        for (int j = 0; j < 4; ++j) gsr[j] = *(const u32x4*)(GS + go + 8 * j);
        { const int win = wi + NW; if (win < NWI) { const int rtn = win & 255, hn = (win >> 8) & 7, bn = win >> 11; AT_LOAD_Q(bn, hn, rtn); AT_LOAD_K(bn, hn, rtn >> 1); AT_LOAD_V(bn, hn, rtn >> 1); } }
        LDS_FENCE();
#pragma unroll
        for (int et = 0; et < 8; ++et)
#pragma unroll
            for (int i = 0; i < 4; ++i) VA[(4 * g + i) * AT_LD + 16 * et + c16] = f2bf(oacc[et][i]);
        LDS_FENCE();
#pragma unroll
        for (int j = 0; j < 4; ++j) { const u32x4 o = *(const LAS u32x4*)(VA + orow * AT_LD + opart * 32 + 8 * j); const u32x4 gw = gsr[j];
            f32x4 v0 = (f32x4){bflo(o.x) * bflo(gw.x), bfhi(o.x) * bfhi(gw.x), bflo(o.y) * bflo(gw.y), bfhi(o.y) * bfhi(gw.y)};
            f32x4 v1 = (f32x4){bflo(o.z) * bflo(gw.z), bfhi(o.z) * bfhi(gw.z), bflo(o.w) * bflo(gw.w), bfhi(o.w) * bfhi(gw.w)};
            *(u32x4*)(SQ + go + 8 * j) = pack8(v0, v1); }
        LDS_FENCE();
    }
#undef AT_LOAD_Q
#undef AT_LOAD_V
#undef AT_LOAD_K
}

DI void scale_rows_part(u16* YM, const float* SSQ, int row0, int nrows, int lane, int wave) {
    f32x4 s[4]; u32x4 w[4][2];
#pragma unroll
    for (int q = 0; q < 4; ++q) { const int m = row0 + wave + 8 * q;
        s[q] = *(const f32x4*)(SSQ + (size_t)m * 16 + (lane >> 4) * 4);
        const u16* p = YM + (size_t)m * DM + lane * 16; w[q][0] = *(const u32x4*)p; w[q][1] = *(const u32x4*)(p + 8); }
#pragma unroll
    for (int q = 0; q < 4; ++q) { const int m = row0 + wave + 8 * q;
        const float rs = 1.0f / sqrtf(((s[q].x + s[q].y) + (s[q].z + s[q].w)) * (1.f / 256.f) + EPS);
        u16* p = YM + (size_t)m * DM + lane * 16;
#pragma unroll
        for (int j = 0; j < 2; ++j) { const u32x4 x = w[q][j];
            f32x4 v0 = (f32x4){bflo(x.x), bfhi(x.x), bflo(x.y), bfhi(x.y)} * rs, v1 = (f32x4){bflo(x.z), bfhi(x.z), bflo(x.w), bfhi(x.w)} * rs;
            *(u32x4*)(p + 8 * j) = pack8(v0, v1); } }
    (void)nrows;
}
struct EpiGateScale {
    static constexpr bool PERM = true;
    EpiAct<1> base; u16* YM; const float* SSQ; mutable int k;
    DI void operator()(const AccT& acc, const Unit& u, int wr, int wc, int fr, int fq) const {
        base(acc, u, wr, wc, fr, fq);
        const int tid = threadIdx.x;
        if (k < 8) scale_rows_part(YM, SSQ, (int)blockIdx.x * 256 + 32 * k, 32, tid & 63, tid >> 6);
        ++k;
    }
};

#define XB_TMO      128
#define XB_XCNT(j)  (256  + 64 * (j))
#define XB_XSUB(j)  (1280 + 64 * (j))
#define XB_XGEN(j)  (2304 + 64 * (j))
#define XB_TOP      3328
#define XB_TOPGEN   3392
#define XCD_BAR_WORDS 3456
#define XB_SPIN_CAP (1u << 18)

__device__ __forceinline__ unsigned xb_ld(unsigned* p)              { return __hip_atomic_load(p, __ATOMIC_RELAXED, __HIP_MEMORY_SCOPE_AGENT); }
__device__ __forceinline__ unsigned xb_add(unsigned* p, unsigned v) { return __hip_atomic_fetch_add(p, v, __ATOMIC_RELAXED, __HIP_MEMORY_SCOPE_AGENT); }
__device__ __forceinline__ unsigned xb_xcc_id() { return (unsigned)__builtin_amdgcn_s_getreg((3 << 11) | 20) & 0xFu; }
#define XB_SPIN(cond, bar) do { unsigned _sp = 0; while (cond) { __builtin_amdgcn_s_sleep(1); \
    if ((++_sp & 255u) == 0u) { if (xb_ld(&(bar)[XB_TMO])) break; if (_sp > XB_SPIN_CAP) { atomicAdd(&(bar)[XB_TMO], 1u); break; } } } } while (0)

struct XcdBarrier {
    unsigned* bar; unsigned x;
    volatile LAS unsigned* st;
};

__device__ __forceinline__ XcdBarrier xcd_barrier_post(unsigned* bar, volatile LAS unsigned* st) {
    XcdBarrier b; b.bar = bar; b.x = xb_xcc_id(); b.st = st;
    if (threadIdx.x == 0) (void)xb_add(&bar[XB_XCNT(b.x)], 1u);
    return b;
}
__device__ __forceinline__ void xcd_barrier_complete(unsigned* bar, unsigned x, unsigned& nloc, unsigned& nx) {
    const unsigned G = gridDim.x * gridDim.y * gridDim.z;
    unsigned sum, cnt, mine, sp = 0u;
    for (;;) {
        sum = 0u; cnt = 0u; mine = 0u;
#pragma unroll
        for (unsigned j = 0; j < 16; ++j) { const unsigned c = xb_ld(&bar[XB_XCNT(j)]); sum += c; cnt += (c > 0u) ? 1u : 0u; mine = (j == x) ? c : mine; }
        if (sum == G) break;
        __builtin_amdgcn_s_sleep(1);
        if ((++sp & 255u) == 0u) { if (xb_ld(&bar[XB_TMO])) break; if (sp > XB_SPIN_CAP) { atomicAdd(&bar[XB_TMO], 1u); break; } }
    }
    nloc = mine > 0u ? mine : 1u; nx = cnt > 0u ? cnt : 1u;
}

__device__ __forceinline__ void xcd_barrier(const XcdBarrier& b) {
    asm volatile("s_waitcnt vmcnt(0)" ::: "memory");
    __syncthreads();
    if (threadIdx.x == 0) {
        unsigned* bar = b.bar;
        __builtin_amdgcn_s_waitcnt(0);
        unsigned nloc = b.st[0], nx = b.st[1];
        if (nloc == 0u) { xcd_barrier_complete(bar, b.x, nloc, nx); b.st[0] = nloc; b.st[1] = nx; }
        const unsigned old = xb_add(&bar[XB_XSUB(b.x)], 1u);
        const unsigned gen = old / nloc;
        if (old + 1u == (gen + 1u) * nloc) {
            __builtin_amdgcn_fence(__ATOMIC_RELEASE, "agent");
            asm volatile("s_waitcnt vmcnt(0)" ::: "memory");
            const unsigned og = xb_add(&bar[XB_TOP], 1u);
            const unsigned tg = og / nx;
            if (og + 1u == (tg + 1u) * nx) xb_add(&bar[XB_TOPGEN], 1u);
            else XB_SPIN(xb_ld(&bar[XB_TOPGEN]) == tg, bar);
            __builtin_amdgcn_fence(__ATOMIC_ACQUIRE, "agent");
            xb_add(&bar[XB_XGEN(b.x)], 1u);
            asm volatile("s_waitcnt vmcnt(0)" ::: "memory");
        } else {
            XB_SPIN(xb_ld(&bar[XB_XGEN(b.x)]) == gen, bar);
            __builtin_amdgcn_fence(__ATOMIC_ACQUIRE, "agent");
            asm volatile("s_waitcnt vmcnt(0)" ::: "memory");
        }
    }
    __syncthreads();
}


__global__ void __launch_bounds__(512, 2) fwd_kernel(Args a) {
    extern __shared__ __attribute__((aligned(16))) unsigned char lds_raw[];
    LAS unsigned char* lds = (LAS unsigned char*)lds_raw;
    cg::grid_group grid = cg::this_grid();
    const int tid = threadIdx.x, lane = tid & 63, wave = __builtin_amdgcn_readfirstlane(tid >> 6);
    const int G = gridDim.x, lo = a.ph_lo, hi = a.ph_hi;
    unsigned char* ws = a.ws;
    u16* WALL = (u16*)(ws + WS_WALL); const float* BIAS = (const float*)(ws + WS_BIAS); u16* HB = (u16*)(ws + WS_H); u16* B6 = (u16*)(ws + WS_B6);
#define IN(k) (lo <= (k) && (k) < hi)
    volatile LAS unsigned* xst = (volatile LAS unsigned*)(lds + LDS_BYTES - 64);
    if (tid < 2) xst[tid] = 0u;
    __syncthreads();
    XcdBarrier xbar = xcd_barrier_post((unsigned*)(ws + WS_BAR), xst);
    if (hi > 1000) grid.sync();
#define SEAM(k) do { if (IN(k) && IN((k) + 1)) xcd_barrier(xbar); } while (0)
    if (IN(0)) { p0_prologue(a, lds, tid, lane, wave); }
    SEAM(0);
    if (IN(1)) {
        { pg8::Gemm g{HB, WALL, MT, 6144, DM}; pg8::StaticOrder S; S.init(MT, 6144, G, (int)blockIdx.x);
          EpiPlain E{B6, BIAS}; pg8::gemm_phase(lds, g, S, E); }
        { pg8::Gemm g{HB, WALL + (size_t)6144 * DM, MT, 2048, DM}; pg8::StaticOrder S; S.init(MT, 2048, G, (int)blockIdx.x);
          EpiGateM E{(u16*)a.out, BIAS + 6144}; pg8::gemm_phase(lds, g, S, E); }
        { pg8::Gemm g{HB, WALL + (size_t)8192 * DM, MT, 1024, DM}; pg8::StaticOrder S; S.init(MT, 1024, G, (int)blockIdx.x);
          EpiAct<0> E{(u16*)a.out + TS, BIAS + 8192}; pg8::gemm_phase(lds, g, S, E); }
    }
    SEAM(1);
    if (IN(2)) {
#ifndef SKIP_ML
        for (int it = blockIdx.x; it < NB * 4 * 4; it += G) mlstm_item(a, lds, it, tid, wave);
#endif
#ifndef SKIP_AT
        __syncthreads();
        attn_phase(a, lds, lane, wave);
#endif
        __syncthreads();
    }
    SEAM(2);
    if (IN(3)) {
        pg8::Gemm g{HB, WALL + (size_t)N1 * DM, MT, 2048, DM}; pg8::StaticOrder S; S.init(MT, 2048, G, (int)blockIdx.x);
        EpiGateScale E{EpiAct<1>{B6, BIAS + N1}, B6 + 2 * TS, (const float*)(ws + WS_SSQ), 0};
        pg8::gemm_phase(lds, g, S, E);
        for (int k = E.k; k < 8; ++k) scale_rows_part(B6 + 2 * TS, (const float*)(ws + WS_SSQ), (int)blockIdx.x * 256 + 32 * k, 32, lane, wave);
    }
    SEAM(3);
    if (IN(4)) {
        u16* T1 = B6 + 5 * TS;
        { pg8::Gemm g{B6 + 2 * TS, (const u16*)(ws + WS_WPM), MT, DM, DM}; pg8::StaticOrder S; S.init(MT, DM, G, (int)blockIdx.x);
          EpiMerge<false> E{B6, T1, B6 + 4 * TS}; pg8::gemm_phase(lds, g, S, E); }
        { pg8::Gemm g{B6 + 3 * TS, (const u16*)(ws + WS_WPS), MT, DM, DM}; pg8::StaticOrder S; S.init(MT, DM, G, (int)blockIdx.x);
          EpiMerge<true> E{B6 + TS, T1, B6 + 4 * TS}; pg8::gemm_phase(lds, g, S, E); }
    }
    SEAM(4);
    if (IN(5)) {
        pg8::Gemm g{B6 + 4 * TS, (const u16*)(ws + WS_WOUT), MT, DM, DM}; pg8::StaticOrder S; S.init(MT, DM, G, (int)blockIdx.x);
        EpiOut E{a.x, a.out};
        pg8::gemm_phase(lds, g, S, E);
    }
#undef IN
#undef SEAM
}

extern "C" void kernel_launch(void* const* d_in, const int* in_sizes, int n_in, void* d_out, int out_size, void* d_ws, size_t ws_size, hipStream_t stream) {
    static int grid = 0;
    if (grid == 0) {
        if (n_in != 12 || in_sizes[0] != MT * DM || out_size != MT * DM || ws_size < WS_END) {
            fprintf(stderr, "kernel_launch: unexpected shapes (n_in %d, in0 %d, out %d, ws %zu); nothing launched\n", n_in, n_in > 0 ? in_sizes[0] : -1, out_size, ws_size); grid = -1; return; }
        int dev = 0, cus = 0, per_cu = 0;
        hipGetDevice(&dev); hipDeviceGetAttribute(&cus, hipDeviceAttributeMultiprocessorCount, dev);
        if (hipFuncSetAttribute((const void*)fwd_kernel, hipFuncAttributeMaxDynamicSharedMemorySize, LDS_BYTES) != hipSuccess) { fprintf(stderr, "kernel_launch: hipFuncSetAttribute failed\n"); grid = -1; return; }
        if (hipOccupancyMaxActiveBlocksPerMultiprocessor(&per_cu, (const void*)fwd_kernel, 512, LDS_BYTES) != hipSuccess || per_cu < 1) { fprintf(stderr, "kernel_launch: occupancy query says %d\n", per_cu); per_cu = 1; }
        (void)hipGetLastError();
        grid = cus;
    }
    if (grid < 0) return;
    Args a{};
    a.x = (const float*)d_in[0]; a.norm_w = (const float*)d_in[1]; a.w_in = (const float*)d_in[2]; a.b_in = (const float*)d_in[3]; a.conv_w = (const float*)d_in[4]; a.conv_b = (const float*)d_in[5];
    a.mnorm_w = (const float*)d_in[6]; a.qn_w = (const float*)d_in[7]; a.kn_w = (const float*)d_in[8]; a.w_pm = (const float*)d_in[9]; a.w_ps = (const float*)d_in[10]; a.w_out = (const float*)d_in[11];
    a.out = (float*)d_out; a.ws = (unsigned char*)d_ws;
    if (hipMemsetAsync(d_ws, 0, WS_BAR + WS_BAR_BYTES, stream) != hipSuccess) { fprintf(stderr, "kernel_launch: hipMemsetAsync failed\n"); return; }
#if MK_N_LAUNCHES == 1
    a.ph_lo = 0; a.ph_hi = NPH;
    void* args[] = {&a};
    hipError_t e = hipLaunchCooperativeKernel((const void*)fwd_kernel, dim3(grid), dim3(512), args, LDS_BYTES, stream);
    if (e != hipSuccess) fprintf(stderr, "kernel_launch: cooperative launch failed: %s (grid %d)\n", hipGetErrorString(e), grid);
#else
    for (int p = 0; p < NPH; ++p) { a.ph_lo = p; a.ph_hi = p + 1; hipLaunchKernelGGL(fwd_kernel, dim3(grid), dim3(512), LDS_BYTES, stream, a); }
#endif
}
```

```cpp
#include <hip/hip_runtime.h>
#include <hip/hip_cooperative_groups.h>
#include <cstdio>
#include <cstdint>
namespace cg = cooperative_groups;

#ifndef MK_N_LAUNCHES
#define MK_N_LAUNCHES 1
#endif

#define DI __device__ __forceinline__
#define LAS __attribute__((address_space(3)))
typedef unsigned short u16;
typedef short bf16x8 __attribute__((ext_vector_type(8)));
typedef short bf16x4 __attribute__((ext_vector_type(4)));
typedef float f32x4 __attribute__((ext_vector_type(4)));
typedef unsigned u32x4 __attribute__((ext_vector_type(4)));
typedef unsigned u32x2 __attribute__((ext_vector_type(2)));

constexpr int DM = 1024, NB = 16, SEQ = 4096, MT = NB * SEQ;
constexpr int IN_COLS = 11272;
constexpr int C_MQ = 0, C_MI = 3072, C_MO = 3080, C_MZ = 4104, C_SQ = 5128, C_SZ = 8200, C_G = 9224;
constexpr int N1 = 9216;
constexpr int NALL = 11264;
constexpr float EPS = 1e-6f;
constexpr size_t MiB = 1u << 20;
constexpr size_t TS = (size_t)MT * DM;
constexpr size_t WS_BAR = 4096, WS_BAR_BYTES = 65536;
constexpr size_t WS_WALL = 1 * MiB, WS_WPM = 23 * MiB, WS_WPS = 25 * MiB, WS_WOUT = 27 * MiB, WS_BIAS = 29 * MiB, WS_IGF = 30 * MiB, WS_SSQ = 32 * MiB,
                 WS_H = 40 * MiB, WS_B6 = 168 * MiB, WS_END = 936 * MiB;
constexpr int LDS_BYTES = 143360;
constexpr int NPH = 6;
#ifndef AT_SHL
#define AT_SHL 0x100
#endif

DI float bf2f(u16 b) { return __uint_as_float(((unsigned)b) << 16); }
DI float bflo(unsigned w) { return __uint_as_float(w << 16); }
DI float bfhi(unsigned w) { return __uint_as_float(w & 0xffff0000u); }
typedef __bf16 bf16v2_t __attribute__((ext_vector_type(2)));
DI unsigned cvt_pk_bf16(float lo, float hi) { bf16v2_t v = {(__bf16)lo, (__bf16)hi}; return __builtin_bit_cast(unsigned, v); }
DI u16 f2bf(float f) { return (u16)(cvt_pk_bf16(f, 0.f) & 0xffffu); }
DI float sigmoidf_(float x) { return __builtin_amdgcn_rcpf(1.0f + __expf(-x)); }
DI float siluf_(float x) { return x * sigmoidf_(x); }
DI float softplus_fast(float z) { return fmaxf(z, 0.f) + __logf(1.0f + __expf(-fabsf(z))); }
DI float wave_sum(float v) {
#pragma unroll
    for (int o = 1; o < 64; o <<= 1) v += __shfl_xor(v, o);
    return v;
}
DI float wave_max(float v) {
#pragma unroll
    for (int o = 1; o < 64; o <<= 1) v = fmaxf(v, __shfl_xor(v, o));
    return v;
}
template <int CTRL> DI float dpp_mov0(float v) { return __builtin_bit_cast(float, __builtin_amdgcn_update_dpp(0, __builtin_bit_cast(int, v), CTRL, 0xF, 0xF, true)); }
DI float row16_sum(float v) { v += dpp_mov0<0xB1>(v); v += dpp_mov0<0x4E>(v); v += dpp_mov0<0x141>(v); v += dpp_mov0<0x140>(v); return v; }
DI float row16_suffix(float v) { v += dpp_mov0<AT_SHL + 1>(v); v += dpp_mov0<AT_SHL + 2>(v); v += dpp_mov0<AT_SHL + 4>(v); v += dpp_mov0<AT_SHL + 8>(v); return v; }
typedef __bf16 bf16v2_d __attribute__((ext_vector_type(2)));
DI float dot2sq(unsigned w, float acc) { const bf16v2_d v = __builtin_bit_cast(bf16v2_d, w); return __builtin_amdgcn_fdot2_f32_bf16(v, v, acc, false); }
DI float sumsq8(u32x4 w, float acc) { return dot2sq(w.w, dot2sq(w.z, dot2sq(w.y, dot2sq(w.x, acc)))); }
#define MFMA16(a, b, c) __builtin_amdgcn_mfma_f32_16x16x32_bf16(a, b, c, 0, 0, 0)
#define LDS_FENCE() asm volatile("s_waitcnt lgkmcnt(0)" ::: "memory")

DI bf16x8 row_frag(const LAS u16* base, int ld, int row, int k) { return *(const LAS bf16x8*)(base + row * ld + k); }
DI bf16x8 tr_frag(const LAS u16* base, int ld, int krow0, int col0, int lane) {
    const int g = lane >> 4, q = (lane & 15) >> 2, p = lane & 3;
    const LAS u16* a0 = base + (krow0 + 8 * g + q) * ld + col0 + 4 * p;
    const bf16x4 lo = __builtin_amdgcn_ds_read_tr16_b64_v4i16((LAS bf16x4*)a0);
    const bf16x4 hi = __builtin_amdgcn_ds_read_tr16_b64_v4i16((LAS bf16x4*)(a0 + 4 * ld));
    return (bf16x8){lo[0], lo[1], lo[2], lo[3], hi[0], hi[1], hi[2], hi[3]};
}

namespace pg8 {
constexpr int BM = 256, BK = 64, HALF = 128, HTB = HALF * BK * 2, STAGE_BYTES = 8 * HTB, NXCD = 8, WGM = 8;
__host__ __device__ __forceinline__ int lds_byte(int r, int c) { const int st = (r >> 4) * 2 + (c >> 5), rr = r & 15, cc = c & 31, ob = rr * 64 + cc * 2; return st * 1024 + (ob ^ (((ob >> 9) & 1) << 5)); }
__host__ __device__ __forceinline__ void stage_rc(int b, int& R, int& C) { const int st = b / 1024, sb = b % 1024, swz = sb ^ (((sb >> 9) & 1) << 5); R = (st >> 1) * 16 + swz / 64; C = (st & 1) * 32 + (swz % 64) / 2; }
__host__ __device__ __forceinline__ int perm32(int rho) { const int n = rho >> 4, i = rho & 15; return 8 * (i >> 2) + 4 * n + (i & 3); }
struct Unit { int pm, pn; };
struct Gemm { const u16* A; const u16* Bt; int M, N, K; };
struct StaticOrder {
    int nM, nN, nwg, G, c;
    __host__ __device__ void init(int M, int N, int G_, int c_) { nM = M / BM; nN = N / BM; nwg = nM * nN; G = G_; c = c_; }
    __host__ __device__ bool next(int i, Unit& u) const {
        const long L = (long)i * G + c; if (L >= nwg) return false;
        int wgid = (int)L; { const int q = nwg / NXCD, r = nwg % NXCD, xcd = wgid % NXCD, off = wgid / NXCD; wgid = (xcd < r ? xcd * (q + 1) : r * (q + 1) + (xcd - r) * q) + off; }
        const int nig = WGM * nN, gid = wgid / nig, fm = gid * WGM, gsz = (nM - fm) < WGM ? (nM - fm) : WGM;
        u.pm = fm + ((wgid % nig) % gsz); u.pn = (wgid % nig) / gsz; return true;
    }
};
template <class Epi, class Sched, bool ALIGN_EPI = true, bool SP2 = true>
__device__ __forceinline__ void gemm_phase(LAS unsigned char* lds, const Gemm g, const Sched& S, const Epi& E) {
    const int tid = threadIdx.x, wid = __builtin_amdgcn_readfirstlane(tid >> 6), lane = tid & 63, wr = wid >> 2, wc = wid & 3, fr = lane & 15, fq = lane >> 4;
    const int K = g.K, nt = K / BK;
    unsigned voffA[2], voffB[2];
#pragma unroll
    for (int i = 0; i < 2; ++i) { int R, C; stage_rc(tid * 16 + i * 8192, R, C); const int Rb = Epi::PERM ? ((R & ~31) + perm32(R & 31)) : R;
        voffA[i] = (unsigned)(R * K + C) * 2u; voffB[i] = (unsigned)(Rb * K + C) * 2u; }
    const size_t kstep = (size_t)(BK * 2);
    const size_t hstep = (size_t)HALF * K * 2;
    const size_t tstep = 2 * hstep;
    const unsigned ldsw = (unsigned)wid * 1024u;
    const int aoff = lds_byte(wr * 64 + fr, fq * 8), boff = lds_byte(wc * 32 + fr, fq * 8);
#define PG8_SA(b, h) (((b) * 2 + (h)) * HTB)
#define PG8_SB(b, h) ((4 + (b) * 2 + (h)) * HTB)
#define PG8_STAGE(bufoff, gbase, voff) do { _Pragma("unroll") for (int _i = 0; _i < 2; ++_i) \
        __builtin_amdgcn_global_load_lds((const unsigned*)((const char*)(gbase) + (voff)[_i]), (LAS unsigned*)(lds + (bufoff) + ldsw + _i * 8192), 16, 0, 0); } while (0)
#define PG8_LDA(dst, b, h) do { _Pragma("unroll") for (int m = 0; m < 4; ++m) _Pragma("unroll") for (int k = 0; k < 2; ++k) dst[m][k] = *(const LAS bf16x8*)(lds + PG8_SA(b, h) + aoff + m * 2048 + k * 1024); } while (0)
#define PG8_LDB(dst, b, h) do { _Pragma("unroll") for (int n = 0; n < 2; ++n) _Pragma("unroll") for (int k = 0; k < 2; ++k) dst[n][k] = *(const LAS bf16x8*)(lds + PG8_SB(b, h) + boff + n * 2048 + k * 1024); } while (0)
#define PG8_MMA(ai, bj, At, Bt) do { __builtin_amdgcn_s_setprio(1); _Pragma("unroll") for (int m = 0; m < 4; ++m) _Pragma("unroll") for (int n = 0; n < 2; ++n) _Pragma("unroll") for (int k = 0; k < 2; ++k) \
        acc[ai][bj][m][n] = __builtin_amdgcn_mfma_f32_16x16x32_bf16(Bt[n][k], At[m][k], acc[ai][bj][m][n], 0, 0, 0); __builtin_amdgcn_s_setprio(0); } while (0)
#define PG8_WAIT_V(n) asm volatile("s_waitcnt vmcnt(" #n ")" ::: "memory")
#define PG8_WAIT_L(n) asm volatile("s_waitcnt lgkmcnt(" #n ")" ::: "memory")
#define PG8_BAR __builtin_amdgcn_s_barrier()
#define PG8_SCHED __builtin_amdgcn_sched_barrier(0)
    Unit cur, nxt; int ui = 0;
    if (!S.next(0, cur)) return;
    f32x4 acc[2][2][4][2];
#pragma unroll
    for (int a = 0; a < 2; ++a)
#pragma unroll
        for (int b = 0; b < 2; ++b)
#pragma unroll
            for (int m = 0; m < 4; ++m)
#pragma unroll
                for (int n = 0; n < 2; ++n) acc[a][b][m][n] = (f32x4){0.f, 0.f, 0.f, 0.f};
    bf16x8 At[4][2], B0[2][2], B1[2][2];
    const char* cA = (const char*)g.A + (size_t)cur.pm * tstep; const char* cB = (const char*)g.Bt + (size_t)cur.pn * tstep;
    if constexpr (SP2) {
        PG8_STAGE(PG8_SB(0, 0), cB, voffB); PG8_STAGE(PG8_SB(0, 1), cB + hstep, voffB); PG8_STAGE(PG8_SA(0, 0), cA, voffA); PG8_STAGE(PG8_SA(0, 1), cA + hstep, voffA);
        if (wr == 1) PG8_BAR;
        PG8_WAIT_V(2); PG8_BAR;
        PG8_STAGE(PG8_SB(1, 0), cB + kstep, voffB); PG8_STAGE(PG8_SA(1, 0), cA + kstep, voffA); PG8_STAGE(PG8_SB(1, 1), cB + hstep + kstep, voffB);
        PG8_WAIT_V(6); PG8_BAR;
    } else {
        PG8_STAGE(PG8_SB(0, 0), cB, voffB); PG8_STAGE(PG8_SA(0, 0), cA, voffA); PG8_STAGE(PG8_SB(0, 1), cB + hstep, voffB); PG8_STAGE(PG8_SA(0, 1), cA + hstep, voffA);
        if (wr == 1) PG8_BAR;
        PG8_WAIT_V(4); PG8_BAR;
        PG8_STAGE(PG8_SB(1, 0), cB + kstep, voffB); PG8_STAGE(PG8_SA(1, 0), cA + kstep, voffA); PG8_STAGE(PG8_SB(1, 1), cB + hstep + kstep, voffB);
        PG8_WAIT_V(6); PG8_BAR;
    }
    for (;;) {
        const bool has_next = S.next(ui + 1, nxt);
        const char* nA = has_next ? (const char*)g.A + (size_t)nxt.pm * tstep : cA; const char* nB = has_next ? (const char*)g.Bt + (size_t)nxt.pn * tstep : cB;
        for (int t = 0; t < nt; t += 2) {
            const bool last = (t == nt - 2);
            const char* a1 = cA + (size_t)(t + 1) * kstep;
            const char* a2 = last ? nA : cA + (size_t)(t + 2) * kstep; const char* b2 = last ? nB : cB + (size_t)(t + 2) * kstep;
            const char* a3 = a2 + kstep; const char* b3 = b2 + kstep;
            if constexpr (SP2) {
            PG8_LDB(B0, 0, 0); PG8_LDB(B1, 0, 1); PG8_SCHED; PG8_LDA(At, 0, 0); PG8_STAGE(PG8_SA(1, 1), a1 + hstep, voffA);
            PG8_WAIT_V(8); PG8_WAIT_L(0); PG8_BAR; PG8_MMA(0, 0, At, B0); PG8_MMA(0, 1, At, B1); PG8_BAR; PG8_SCHED;
            PG8_LDA(At, 0, 1); PG8_STAGE(PG8_SB(0, 0), b2, voffB); PG8_STAGE(PG8_SB(0, 1), b2 + hstep, voffB); PG8_STAGE(PG8_SA(0, 0), a2, voffA);
            PG8_WAIT_V(8); PG8_WAIT_L(0); PG8_BAR; PG8_MMA(1, 0, At, B0); PG8_MMA(1, 1, At, B1); PG8_BAR; PG8_SCHED;
            PG8_LDB(B0, 1, 0); PG8_LDB(B1, 1, 1); PG8_SCHED; PG8_LDA(At, 1, 0); PG8_STAGE(PG8_SA(0, 1), a2 + hstep, voffA);
            PG8_WAIT_V(8); PG8_WAIT_L(0); PG8_BAR; PG8_MMA(0, 0, At, B0); PG8_MMA(0, 1, At, B1); PG8_BAR; PG8_SCHED;
            PG8_LDA(At, 1, 1); PG8_STAGE(PG8_SB(1, 0), b3, voffB); PG8_STAGE(PG8_SB(1, 1), b3 + hstep, voffB); PG8_STAGE(PG8_SA(1, 0), a3, voffA);
            PG8_WAIT_V(8); PG8_WAIT_L(0); PG8_BAR; PG8_MMA(1, 0, At, B0); PG8_MMA(1, 1, At, B1); PG8_BAR; PG8_SCHED;
            } else {
            PG8_LDB(B0, 0, 0); PG8_SCHED; PG8_LDA(At, 0, 0); PG8_STAGE(PG8_SA(1, 1), a1 + hstep, voffA);
            PG8_WAIT_L(8); PG8_BAR; PG8_WAIT_L(0); PG8_MMA(0, 0, At, B0); PG8_BAR; PG8_SCHED;
            PG8_LDB(B1, 0, 1); PG8_STAGE(PG8_SB(0, 0), b2, voffB);
            PG8_BAR; PG8_WAIT_L(0); PG8_MMA(0, 1, At, B1); PG8_BAR;
            PG8_LDA(At, 0, 1); PG8_STAGE(PG8_SA(0, 0), a2, voffA);
            PG8_BAR; PG8_WAIT_L(0); PG8_MMA(1, 0, At, B0); PG8_BAR; PG8_SCHED;
            PG8_STAGE(PG8_SB(0, 1), b2 + hstep, voffB);
            PG8_WAIT_V(6); PG8_BAR; PG8_MMA(1, 1, At, B1); PG8_BAR;
            PG8_LDB(B0, 1, 0); PG8_SCHED; PG8_LDA(At, 1, 0); PG8_STAGE(PG8_SA(0, 1), a2 + hstep, voffA);
            PG8_WAIT_L(8); PG8_BAR; PG8_WAIT_L(0); PG8_MMA(0, 0, At, B0); PG8_BAR; PG8_SCHED;
            PG8_LDB(B1, 1, 1); PG8_STAGE(PG8_SB(1, 0), b3, voffB);
            PG8_BAR; PG8_WAIT_L(0); PG8_MMA(0, 1, At, B1); PG8_BAR;
            PG8_LDA(At, 1, 1); PG8_STAGE(PG8_SA(1, 0), a3, voffA);
            PG8_BAR; PG8_WAIT_L(0); PG8_MMA(1, 0, At, B0); PG8_BAR; PG8_SCHED;
            PG8_STAGE(PG8_SB(1, 1), b3 + hstep, voffB);
            PG8_WAIT_V(6); PG8_BAR; PG8_MMA(1, 1, At, B1); PG8_BAR;
            }
        }
        if constexpr (ALIGN_EPI) { if (wr == 0) PG8_BAR; }
        E(acc, cur, wr, wc, fr, fq);
        if (!has_next) break;
#pragma unroll
        for (int a = 0; a < 2; ++a)
#pragma unroll
            for (int b = 0; b < 2; ++b)
#pragma unroll
                for (int m = 0; m < 4; ++m)
#pragma unroll
                    for (int n = 0; n < 2; ++n) acc[a][b][m][n] = (f32x4){0.f, 0.f, 0.f, 0.f};
        cur = nxt; cA = nA; cB = nB; ++ui;
        if constexpr (ALIGN_EPI) { if (wr == 1) PG8_BAR; }
    }
    PG8_WAIT_V(0);
    if constexpr (!ALIGN_EPI) { if (wr == 0) PG8_BAR; }
    PG8_BAR;
#undef PG8_SA
#undef PG8_SB
#undef PG8_STAGE
#undef PG8_LDA
#undef PG8_LDB
#undef PG8_MMA
#undef PG8_WAIT_V
#undef PG8_WAIT_L
#undef PG8_BAR
#undef PG8_SCHED
}
}
using pg8::Unit;
typedef f32x4 AccT[2][2][4][2];

DI u32x4 pack8(f32x4 v0, f32x4 v1) { u32x4 w; w.x = cvt_pk_bf16(v0[0], v0[1]); w.y = cvt_pk_bf16(v0[2], v0[3]); w.z = cvt_pk_bf16(v1[0], v1[1]); w.w = cvt_pk_bf16(v1[2], v1[3]); return w; }
struct EpiPlain {
    static constexpr bool PERM = true;
    u16* buf6; const float* bias;
    DI void operator()(const AccT& acc, const Unit& u, int wr, int wc, int fr, int fq) const {
        const int row0 = u.pm * 256 + wr * 64 + fr, bcol0 = u.pn * 256 + wc * 32 + 8 * fq;
        f32x4 bv[2][2];
#pragma unroll
        for (int bj = 0; bj < 2; ++bj)
#pragma unroll
            for (int n = 0; n < 2; ++n) bv[bj][n] = *(const f32x4*)(bias + bcol0 + bj * 128 + 4 * n);
        u16* base = buf6 + (size_t)(u.pn >> 2) * TS; const int col0 = (u.pn & 3) * 256 + wc * 32 + 8 * fq;
#pragma unroll
        for (int ai = 0; ai < 2; ++ai)
#pragma unroll
            for (int m = 0; m < 4; ++m) { u16* rowp = base + (size_t)(row0 + ai * 128 + m * 16) * DM + col0;
#pragma unroll
                for (int bj = 0; bj < 2; ++bj) *(u32x4*)(rowp + bj * 128) = pack8(acc[ai][bj][m][0] + bv[bj][0], acc[ai][bj][m][1] + bv[bj][1]); }
    }
};
struct EpiGateM {
    static constexpr bool PERM = true;
    u16* gate_m; const float* bias;
    DI void operator()(const AccT& acc, const Unit& u, int wr, int wc, int fr, int fq) const {
        const int row0 = u.pm * 256 + wr * 64 + fr, bcol0 = u.pn * 256 + wc * 32 + 8 * fq;
        f32x4 bv[2][2];
#pragma unroll
        for (int bj = 0; bj < 2; ++bj)
#pragma unroll
            for (int n = 0; n < 2; ++n) bv[bj][n] = *(const f32x4*)(bias + bcol0 + bj * 128 + 4 * n);
        const int col0 = u.pn * 128 + wc * 32 + 8 * fq;
#pragma unroll
        for (int ai = 0; ai < 2; ++ai)
#pragma unroll
            for (int m = 0; m < 4; ++m) { u16* rowp = gate_m + (size_t)(row0 + ai * 128 + m * 16) * DM + col0;
                f32x4 r[2];
#pragma unroll
                for (int n = 0; n < 2; ++n) { const f32x4 o = acc[ai][0][m][n] + bv[0][n], z = acc[ai][1][m][n] + bv[1][n];
#pragma unroll
                    for (int j = 0; j < 4; ++j) r[n][j] = z[j] * __builtin_amdgcn_rcpf((1.0f + __expf(-o[j])) * (1.0f + __expf(-z[j]))); }
                *(u32x4*)rowp = pack8(r[0], r[1]); }
    }
};
template <int ACT> struct EpiAct {
    static constexpr bool PERM = true;
    u16* out2; const float* bias;
    DI void operator()(const AccT& acc, const Unit& u, int wr, int wc, int fr, int fq) const {
        const int row0 = u.pm * 256 + wr * 64 + fr, bcol0 = u.pn * 256 + wc * 32 + 8 * fq;
        u16* base = out2 + (size_t)(u.pn >> 2) * TS; const int col0 = (u.pn & 3) * 256 + wc * 32 + 8 * fq;
        f32x4 bv[2][2];
#pragma unroll
        for (int bj = 0; bj < 2; ++bj)
#pragma unroll
            for (int n = 0; n < 2; ++n) bv[bj][n] = *(const f32x4*)(bias + bcol0 + bj * 128 + 4 * n);
#pragma unroll
        for (int ai = 0; ai < 2; ++ai)
#pragma unroll
            for (int m = 0; m < 4; ++m) { u16* rowp = base + (size_t)(row0 + ai * 128 + m * 16) * DM + col0;
#pragma unroll
                for (int bj = 0; bj < 2; ++bj) { f32x4 r[2];
#pragma unroll
                    for (int n = 0; n < 2; ++n) { const f32x4 z = acc[ai][bj][m][n] + bv[bj][n];
#pragma unroll
                        for (int j = 0; j < 4; ++j) r[n][j] = ACT ? sigmoidf_(z[j]) : siluf_(z[j]); }
                    *(u32x4*)(rowp + bj * 128) = pack8(r[0], r[1]); } }
    }
};
template <bool SECOND> struct EpiMerge {
    static constexpr bool PERM = true;
    const u16* g; u16* t1; u16* merged;
    DI void operator()(const AccT& acc, const Unit& u, int wr, int wc, int fr, int fq) const {
        const int row0 = u.pm * 256 + wr * 64 + fr, col0 = u.pn * 256 + wc * 32 + 8 * fq;
#pragma unroll
        for (int ai = 0; ai < 2; ++ai) {
            u32x4 gw[4][2], tw[4][2];
#pragma unroll
            for (int m = 0; m < 4; ++m)
#pragma unroll
                for (int bj = 0; bj < 2; ++bj) { const size_t o = (size_t)(row0 + ai * 128 + m * 16) * DM + col0 + bj * 128;
                    gw[m][bj] = *(const u32x4*)(g + o); if (SECOND) tw[m][bj] = *(const u32x4*)(t1 + o); }
#pragma unroll
            for (int m = 0; m < 4; ++m)
#pragma unroll
                for (int bj = 0; bj < 2; ++bj) { const size_t o = (size_t)(row0 + ai * 128 + m * 16) * DM + col0 + bj * 128;
                    const u32x4 gq = gw[m][bj];
                    f32x4 g0 = (f32x4){bflo(gq.x), bfhi(gq.x), bflo(gq.y), bfhi(gq.y)}, g1 = (f32x4){bflo(gq.z), bfhi(gq.z), bflo(gq.w), bfhi(gq.w)};
                    f32x4 v0 = g0 * acc[ai][bj][m][0], v1 = g1 * acc[ai][bj][m][1];
                    if (!SECOND) { *(u32x4*)(t1 + o) = pack8(v0, v1); }
                    else { const u32x4 tq = tw[m][bj];
                        v0 += (f32x4){bflo(tq.x), bfhi(tq.x), bflo(tq.y), bfhi(tq.y)}; v1 += (f32x4){bflo(tq.z), bfhi(tq.z), bflo(tq.w), bfhi(tq.w)};
                        *(u32x4*)(merged + o) = pack8(v0, v1); } }
        }
    }
};
struct EpiOut {
    static constexpr bool PERM = false;
    const float* x; float* out;
    DI void operator()(const AccT& acc, const Unit& u, int wr, int wc, int fr, int fq) const {
        const int row0 = u.pm * 256 + wr * 64 + fr, col0 = u.pn * 256 + wc * 32 + 4 * fq;
#pragma unroll
        for (int ai = 0; ai < 2; ++ai) {
            f32x4 xv[4][2][2];
#pragma unroll
            for (int m = 0; m < 4; ++m)
#pragma unroll
                for (int bj = 0; bj < 2; ++bj)
#pragma unroll
                    for (int n = 0; n < 2; ++n) xv[m][bj][n] = *(const f32x4*)(x + (size_t)(row0 + ai * 128 + m * 16) * DM + col0 + bj * 128 + n * 16);
#pragma unroll
            for (int m = 0; m < 4; ++m)
#pragma unroll
                for (int bj = 0; bj < 2; ++bj)
#pragma unroll
                    for (int n = 0; n < 2; ++n) *(f32x4*)(out + (size_t)(row0 + ai * 128 + m * 16) * DM + col0 + bj * 128 + n * 16) = xv[m][bj][n] + acc[ai][bj][m][n];
        }
    }
};

struct Args {
    const float* x; const float* norm_w; const float* w_in; const float* b_in; const float* conv_w; const float* conv_b; const float* mnorm_w;
    const float* qn_w; const float* kn_w; const float* w_pm; const float* w_ps; const float* w_out;
    float* out; unsigned char* ws; int ph_lo, ph_hi;
};

__host__ __device__ __forceinline__ int src_col_of(int r0) {
    if (r0 < 3072) return r0;
    if (r0 < 6144) return C_SQ + (r0 - 3072);
    if (r0 < 8192) { const int q = r0 - 6144, j = q >> 8, w = q & 255; return w < 128 ? C_MO + 128 * j + w : C_MZ + 128 * j + (w - 128); }
    if (r0 < 9216) return C_SZ + (r0 - 8192);
    return C_G + (r0 - 9216);
}
DI void p0_transpose_item(const float* W, int ldw, int src0, u16* WT, int dst0, int k0, LAS float* scr, int lane) {
    float tv[32];
#pragma unroll
    for (int i = 0; i < 32; ++i) tv[i] = W[(size_t)(k0 + 2 * i + (lane >> 5)) * ldw + src0 + (lane & 31)];
#pragma unroll
    for (int i = 0; i < 32; ++i) scr[(2 * i + (lane >> 5)) * 33 + (lane & 31)] = tv[i];
    LDS_FENCE();
    const int c = lane & 7;
#pragma unroll
    for (int j = 0; j < 4; ++j) { const int n = (lane >> 3) + 8 * j; const LAS float* s = scr + (8 * c) * 33 + n;
        u32x4 o; o.x = cvt_pk_bf16(s[0 * 33], s[1 * 33]); o.y = cvt_pk_bf16(s[2 * 33], s[3 * 33]); o.z = cvt_pk_bf16(s[4 * 33], s[5 * 33]); o.w = cvt_pk_bf16(s[6 * 33], s[7 * 33]);
        *(u32x4*)(WT + (size_t)(dst0 + n) * DM + k0 + 8 * c) = o; }
    LDS_FENCE();
}
DI void p0_prologue(const Args& a, LAS unsigned char* lds, int tid, int lane, int wave) {
    unsigned char* ws = a.ws;
    u16* WALL = (u16*)(ws + WS_WALL); float* BIAS = (float*)(ws + WS_BIAS); float* IGF = (float*)(ws + WS_IGF); u16* HB = (u16*)(ws + WS_H);
    const int G = gridDim.x, gw = blockIdx.x * 8 + wave, NGW = G * 8;
    LAS float* scr = (LAS float*)(lds + wave * 8448);
    LAS float* W8 = (LAS float*)(lds + 8 * 8448);
    for (int i = tid; i < 8 * 1024; i += 512) { const int c = i >> 10, k = i & 1023; W8[i] = a.w_in[(size_t)k * IN_COLS + C_MI + c]; }
    constexpr int I_ALL = (NALL / 32) * 16, I_P = 32 * 16, NITEMS = I_ALL + 3 * I_P;
    for (int it = gw; it < NITEMS; it += NGW) {
        if (it < I_ALL) { const int db = it >> 4, kb = it & 15; p0_transpose_item(a.w_in, IN_COLS, src_col_of(db * 32), WALL, db * 32, kb * 64, scr, lane); }
        else { int r = it - I_ALL; const int which = r / I_P; r -= which * I_P; const int db = r >> 4, kb = r & 15;
            const float* W = which == 0 ? a.w_pm : (which == 1 ? a.w_ps : a.w_out); u16* WT = (u16*)(ws + (which == 0 ? WS_WPM : (which == 1 ? WS_WPS : WS_WOUT)));
            p0_transpose_item(W, DM, db * 32, WT, db * 32, kb * 64, scr, lane); }
    }
    for (int i = blockIdx.x * 512 + tid; i < NALL; i += G * 512) BIAS[i] = a.b_in[src_col_of(i)];
    __syncthreads();
    f32x4 nw[4];
#pragma unroll
    for (int j = 0; j < 4; ++j) nw[j] = *(const f32x4*)(a.norm_w + 256 * j + 4 * lane);
    const float bg = lane < 8 ? a.b_in[C_MI + lane] : 0.f;
    for (int m0 = gw * 4; m0 < MT; m0 += NGW * 4) {
        f32x4 v[4][4]; float rstd[4];
#pragma unroll
        for (int r = 0; r < 4; ++r) { const f32x4* xr = (const f32x4*)(a.x + (size_t)(m0 + r) * DM) + lane;
#pragma unroll
            for (int j = 0; j < 4; ++j) v[r][j] = xr[64 * j]; }
#pragma unroll
        for (int r = 0; r < 4; ++r) { float s2 = 0.f;
#pragma unroll
            for (int j = 0; j < 4; ++j) s2 += (v[r][j].x * v[r][j].x + v[r][j].y * v[r][j].y) + (v[r][j].z * v[r][j].z + v[r][j].w * v[r][j].w);
            rstd[r] = 1.0f / sqrtf(wave_sum(s2) * (1.f / DM) + EPS); }
#pragma unroll
        for (int r = 0; r < 4; ++r) {
#pragma unroll
            for (int j = 0; j < 4; ++j) v[r][j] = v[r][j] * rstd[r] * nw[j];
            unsigned long long* o8 = (unsigned long long*)(HB + (size_t)(m0 + r) * DM) + lane;
#pragma unroll
            for (int j = 0; j < 4; ++j) o8[64 * j] = (unsigned long long)cvt_pk_bf16(v[r][j].x, v[r][j].y) | ((unsigned long long)cvt_pk_bf16(v[r][j].z, v[r][j].w) << 32);
        }
        float d8[4][8];
#pragma unroll
        for (int c = 0; c < 8; ++c) { f32x4 w[4];
#pragma unroll
            for (int j = 0; j < 4; ++j) w[j] = *(const LAS f32x4*)(W8 + c * 1024 + 256 * j + 4 * lane);
#pragma unroll
            for (int r = 0; r < 4; ++r) { float d = 0.f;
#pragma unroll
                for (int j = 0; j < 4; ++j) d += (v[r][j].x * w[j].x + v[r][j].y * w[j].y) + (v[r][j].z * w[j].z + v[r][j].w * w[j].w);
                d8[r][c] = d; } }
#pragma unroll
        for (int r = 0; r < 4; ++r) {
            float d4[4], d2[2], d1;
            { const bool up = lane & 1;
#pragma unroll
              for (int i = 0; i < 4; ++i) { const float keep = up ? d8[r][2 * i + 1] : d8[r][2 * i], give = up ? d8[r][2 * i] : d8[r][2 * i + 1]; d4[i] = keep + __shfl_xor(give, 1); } }
            { const bool up = lane & 2;
#pragma unroll
              for (int i = 0; i < 2; ++i) { const float keep = up ? d4[2 * i + 1] : d4[2 * i], give = up ? d4[2 * i] : d4[2 * i + 1]; d2[i] = keep + __shfl_xor(give, 2); } }
            { const bool up = lane & 4; const float keep = up ? d2[1] : d2[0], give = up ? d2[0] : d2[1]; d1 = keep + __shfl_xor(give, 4); }
            d1 += __shfl_xor(d1, 8); d1 += __shfl_xor(d1, 16); d1 += __shfl_xor(d1, 32);
            if (lane < 8) { float p = d1 + bg; if (lane >= 4) p = fminf(p, 0.f) - log1pf(expf(-fabsf(p))); IGF[(size_t)(m0 + r) * 8 + lane] = p; }
        }
    }
    __syncthreads();
}

constexpr int ML_LDQ = 264, ML_LDV = 88, ML_LDP = 72, ML_LDH = 68;
constexpr int ML_QS = 0, ML_KS = 33792, ML_VS = 67584, ML_PS = 78848, ML_CS = 88064, ML_VEC = 130304, ML_CW = 131904;
static_assert(ML_CW + 10240 <= LDS_BYTES, "mLSTM LDS map");
DI void mlstm_item(const Args& a, LAS unsigned char* lds, int item, int tid, int wave) {
    unsigned char* ws = a.ws;
    const u16* MQ = (const u16*)(ws + WS_B6); const u16* MK = MQ + TS; u16* MV = (u16*)(ws + WS_B6) + 2 * TS;
    const float* IGF = (const float*)(ws + WS_IGF); float* SSQ = (float*)(ws + WS_SSQ); const u16* GM = (const u16*)a.out;
    const int es = item & 3, h = (item >> 2) & 3, b = item >> 4;
    LAS u16* QS = (LAS u16*)(lds + ML_QS); LAS u16* KS = (LAS u16*)(lds + ML_KS); LAS u16* VS = (LAS u16*)(lds + ML_VS); LAS u16* PS = (LAS u16*)(lds + ML_PS); LAS u16* CS = (LAS u16*)(lds + ML_CS);
    LAS float* HS = (LAS float*)(lds + ML_QS);
    LAS float* bcum = (LAS float*)(lds + ML_VEC); LAS float* avec = bcum + 64; LAS float* mtv = bcum + 128; LAS float* wint = bcum + 192; LAS float* wsv = bcum + 256; LAS float* denv = bcum + 320; LAS float* misc = bcum + 384;
    LAS float* CW = (LAS float*)(lds + ML_CW);
    __syncthreads();
    for (int i = tid; i < 2560; i += 512) { const int kq = i >= 1280, r = i - kq * 1280; const int ch = kq * 1024 + h * 256 + (r & 255);
        CW[i] = r < 1024 ? a.conv_w[(size_t)(r >> 8) * 2048 + ch] : a.conv_b[ch]; }
    for (int i = tid; i < 80 * ML_LDQ / 2; i += 512) ((LAS unsigned*)CS)[i] = 0u;
    f32x4 accC[5][2];
#pragma unroll
    for (int et = 0; et < 5; ++et)
#pragma unroll
        for (int dt = 0; dt < 2; ++dt) accC[et][dt] = (f32x4){0.f, 0.f, 0.f, 0.f};
    float m_prev = 0.f;
    u32x4 rq[7], rk[7], vnext, gnext; float ign = 0.f, lfn = 0.f;
#define ML_LOAD_CHUNK(cc) do { \
        int tl_ = tid; asm volatile("" : "+v"(tl_)); \
        const int dg_ = tl_ & 31, seg_ = tl_ >> 5, orow_ = tl_ >> 3, opiece_ = tl_ & 7; \
        const u16* sq_ = MQ + h * 256 + dg_ * 8; const u16* sk_ = MK + h * 256 + dg_ * 8; \
        _Pragma("unroll") for (int jj = 0; jj < 7; ++jj) { const int sp = (cc) * 64 + 4 * seg_ - 3 + jj; \
            rq[jj] = sp >= 0 ? *(const u32x4*)(sq_ + ((size_t)b * SEQ + sp) * DM) : (u32x4){0u, 0u, 0u, 0u}; \
            rk[jj] = sp >= 0 ? *(const u32x4*)(sk_ + ((size_t)b * SEQ + sp) * DM) : (u32x4){0u, 0u, 0u, 0u}; } \
        vnext = *(const u32x4*)(MV + ((size_t)b * SEQ + (size_t)(cc) * 64 + orow_) * DM + h * 256 + es * 64 + opiece_ * 8); \
        gnext = *(const u32x4*)(GM + ((size_t)b * SEQ + (size_t)(cc) * 64 + orow_) * DM + h * 256 + es * 64 + opiece_ * 8); \
        if (wave == 0) { const size_t tg_ = ((size_t)b * SEQ + (size_t)(cc) * 64 + (tl_ & 63)) * 8; ign = IGF[tg_ + h]; lfn = IGF[tg_ + 4 + h]; } \
    } while (0)
    ML_LOAD_CHUNK(0);
    float nwv[8];
    { const int op_ = tid & 7;
#pragma unroll
      for (int j = 0; j < 8; ++j) nwv[j] = a.mnorm_w[h * 256 + es * 64 + op_ * 8 + j]; }
    __syncthreads();
    for (int c = 0; c < 64; ++c) {
        const size_t tokc = (size_t)b * SEQ + (size_t)c * 64;
        int tl = tid; asm volatile("" : "+v"(tl));
        const int lane = tl & 63, g = lane >> 4, c16 = lane & 15;
        const int orow = tl >> 3, opiece = tl & 7;
        const int dg = tl & 31, seg = tl >> 5;
#pragma unroll
        for (int kq = 0; kq < 2; ++kq) {
            const LAS float* cw = CW + kq * 1280 + dg * 8;
            f32x4 wt[4][2], bb[2];
#pragma unroll
            for (int j = 0; j < 4; ++j) { wt[j][0] = *(const LAS f32x4*)(cw + j * 256); wt[j][1] = *(const LAS f32x4*)(cw + j * 256 + 4); }
            bb[0] = *(const LAS f32x4*)(cw + 1024); bb[1] = *(const LAS f32x4*)(cw + 1028);
#pragma unroll
            for (int rr = 0; rr < 4; ++rr) {
                f32x4 s0 = bb[0], s1 = bb[1];
#pragma unroll
                for (int j = 0; j < 4; ++j) { const u32x4 w = kq ? rk[rr + j] : rq[rr + j];
                    s0 += wt[j][0] * (f32x4){bflo(w.x), bfhi(w.x), bflo(w.y), bfhi(w.y)}; s1 += wt[j][1] * (f32x4){bflo(w.z), bfhi(w.z), bflo(w.w), bfhi(w.w)}; }
#pragma unroll
                for (int j = 0; j < 4; ++j) { s0[j] = siluf_(s0[j]); s1[j] = siluf_(s1[j]); }
                *(LAS u32x4*)((kq ? KS : QS) + (4 * seg + rr) * ML_LDQ + dg * 8) = pack8(s0, s1);
            }
        }
        const u32x4 vreg = vnext, gw = gnext;
        *(LAS u32x4*)(VS + orow * ML_LDV + opiece * 8) = vreg;
        if (opiece == 0) { *(LAS u32x4*)(VS + orow * ML_LDV + 64) = (u32x4){0x3F80u, 0u, 0u, 0u}; *(LAS u32x4*)(VS + orow * ML_LDV + 72) = (u32x4){0u, 0u, 0u, 0u}; }
        if (wave == 0) {
            const float ig = ign, lf = lfn;
            float bc = lf;
#pragma unroll
            for (int o = 1; o < 64; o <<= 1) { const float t = __shfl_up(bc, o); if (lane >= o) bc += t; }
            const float av = ig - bc; float pm = av;
#pragma unroll
            for (int o = 1; o < 64; o <<= 1) { const float t = __shfl_up(pm, o); if (lane >= o) pm = fmaxf(pm, t); }
            const float inter = bc + m_prev, mt = fmaxf(inter, bc + pm);
            const float blast = __shfl(bc, 63), dec = blast + av;
            const float mnew = fmaxf(blast + m_prev, wave_max(dec));
            bcum[lane] = bc; avec[lane] = av; mtv[lane] = mt; wint[lane] = __expf(inter - mt); wsv[lane] = __expf(dec - mnew);
            if (lane == 0) misc[0] = __expf(blast + m_prev - mnew);
            m_prev = mnew;
        }
        if (c + 1 < 64) ML_LOAD_CHUNK(c + 1);
        __syncthreads();
        {
            const int tt = wave >> 1;
#pragma unroll
            for (int si = 0; si < 2; ++si) { const int st = (wave & 1) * 2 + si;
                f32x4 s = (f32x4){0.f, 0.f, 0.f, 0.f};
                if (st <= tt) {
#pragma unroll
                    for (int ks = 0; ks < 8; ++ks) s = MFMA16(row_frag(KS, ML_LDQ, 16 * st + c16, 32 * ks + 8 * g), row_frag(QS, ML_LDQ, 16 * tt + c16, 32 * ks + 8 * g), s);
                }
                const int t = 16 * tt + c16, s0 = 16 * st + 4 * g; const float bt_ = bcum[t] - mtv[t]; const f32x4 as = *(const LAS f32x4*)(avec + s0);
                f32x4 v;
#pragma unroll
                for (int i = 0; i < 4; ++i) v[i] = (s0 + i) <= t ? s[i] * (0.0625f * __expf(bt_ + as[i])) : 0.f;
                u32x2 w; w.x = cvt_pk_bf16(v[0], v[1]); w.y = cvt_pk_bf16(v[2], v[3]);
                *(LAS u32x2*)(PS + t * ML_LDP + s0) = w; }
        }
        __syncthreads();
        const int tt = wave & 3, et0 = wave < 4 ? 0 : 3, net = wave < 4 ? 3 : 2;
        const int tq = 16 * tt + c16;
        f32x4 num[3];
        { const float wi = wint[tq];
#pragma unroll
        for (int ei = 0; ei < 3; ++ei) {
            num[ei] = (f32x4){0.f, 0.f, 0.f, 0.f};
            if (ei < net) { const int et = et0 + ei;
                f32x4 a1 = (f32x4){0.f, 0.f, 0.f, 0.f}, a2 = (f32x4){0.f, 0.f, 0.f, 0.f};
#pragma unroll
                for (int ks = 0; ks < 2; ++ks) a1 = MFMA16(tr_frag(VS, ML_LDV, 32 * ks, 16 * et, lane), row_frag(PS, ML_LDP, 16 * tt + c16, 32 * ks + 8 * g), a1);
#pragma unroll
                for (int ks = 0; ks < 8; ++ks) a2 = MFMA16(row_frag(CS, ML_LDQ, 16 * et + c16, 32 * ks + 8 * g), row_frag(QS, ML_LDQ, 16 * tt + c16, 32 * ks + 8 * g), a2);
                num[ei] = a1 + a2 * wi;
                if (et == 4 && g == 0) denv[tq] = num[ei][0];
            }
        } }
        __syncthreads();
        { const float rden = __builtin_amdgcn_rcpf(fmaxf(fabsf(denv[tq]), __expf(-mtv[tq])));
#pragma unroll
          for (int ei = 0; ei < 3; ++ei) if (ei < net && et0 + ei < 4) *(LAS f32x4*)(HS + tq * ML_LDH + 16 * (et0 + ei) + 4 * g) = num[ei] * rden; }
        {
            const float w = wsv[orow] * 0.0625f;
            f32x4 v0 = (f32x4){bflo(vreg.x), bfhi(vreg.x), bflo(vreg.y), bfhi(vreg.y)} * w, v1 = (f32x4){bflo(vreg.z), bfhi(vreg.z), bflo(vreg.w), bfhi(vreg.w)} * w;
            *(LAS u32x4*)(VS + orow * ML_LDV + opiece * 8) = pack8(v0, v1);
            if (opiece == 0) VS[orow * ML_LDV + 64] = f2bf(w);
        }
        __syncthreads();
        {
            const f32x4 h0 = *(const LAS f32x4*)(HS + orow * ML_LDH + opiece * 8), h1 = *(const LAS f32x4*)(HS + orow * ML_LDH + opiece * 8 + 4);
            float ss = (h0.x * h0.x + h0.y * h0.y) + (h0.z * h0.z + h0.w * h0.w) + (h1.x * h1.x + h1.y * h1.y) + (h1.z * h1.z + h1.w * h1.w);
            ss += __shfl_xor(ss, 1); ss += __shfl_xor(ss, 2); ss += __shfl_xor(ss, 4);
            if (opiece == 0) SSQ[(tokc + orow) * 16 + h * 4 + es] = ss;
            const size_t go = (tokc + orow) * DM + h * 256 + es * 64 + opiece * 8;
            f32x4 y0, y1;
            y0[0] = h0.x * nwv[0] * bflo(gw.x); y0[1] = h0.y * nwv[1] * bfhi(gw.x); y0[2] = h0.z * nwv[2] * bflo(gw.y); y0[3] = h0.w * nwv[3] * bfhi(gw.y);
            y1[0] = h1.x * nwv[4] * bflo(gw.z); y1[1] = h1.y * nwv[5] * bfhi(gw.z); y1[2] = h1.z * nwv[6] * bflo(gw.w); y1[3] = h1.w * nwv[7] * bfhi(gw.w);
            *(u32x4*)(MV + go) = pack8(y0, y1);
        }
        {
            const float cs = misc[0];
#pragma unroll
            for (int et = 0; et < 5; ++et)
#pragma unroll
                for (int dt = 0; dt < 2; ++dt) accC[et][dt] = accC[et][dt] * cs;
#pragma unroll
            for (int ks = 0; ks < 2; ++ks) {
                bf16x8 kb[2];
#pragma unroll
                for (int dt = 0; dt < 2; ++dt) kb[dt] = tr_frag(KS, ML_LDQ, 32 * ks, 32 * wave + 16 * dt, lane);
#pragma unroll
                for (int et = 0; et < 5; ++et) { const bf16x8 va = tr_frag(VS, ML_LDV, 32 * ks, 16 * et, lane);
#pragma unroll
                    for (int dt = 0; dt < 2; ++dt) accC[et][dt] = MFMA16(kb[dt], va, accC[et][dt]); }
            }
#pragma unroll
            for (int et = 0; et < 5; ++et)
#pragma unroll
                for (int dt = 0; dt < 2; ++dt)
                    { u32x2 w; w.x = cvt_pk_bf16(accC[et][dt][0], accC[et][dt][1]); w.y = cvt_pk_bf16(accC[et][dt][2], accC[et][dt][3]);
                      *(LAS u32x2*)(CS + (16 * et + c16) * ML_LDQ + 32 * wave + 16 * dt + 4 * g) = w; }
        }
        __syncthreads();
    }
#undef ML_LOAD_CHUNK
}

constexpr float SB_CUT = 20.0f;
constexpr int AT_LD = 136, AT_LDL = 40, AT_WSZ = 12288;
static_assert(8 * AT_WSZ <= LDS_BYTES && 32 * AT_LD * 2 + 2 * 16 * AT_LDL * 2 <= AT_WSZ, "attention LDS map");
DI void attn_phase(const Args& a, LAS unsigned char* lds, int lane, int wave) {
    unsigned char* ws = a.ws;
    u16* SQ = (u16*)(ws + WS_B6) + 3 * TS; const u16* SK = SQ + TS; const u16* SV = SQ + 2 * TS; const u16* GS = (const u16*)a.out + TS;
    constexpr int NWI = NB * 8 * 256;
    const int NW = gridDim.x * 8;
    const int g = lane >> 4, c16 = lane & 15;
    LAS u16* VA = (LAS u16*)(lds + wave * AT_WSZ); LAS u16* L1H = VA + 32 * AT_LD; LAS u16* L1L = L1H + 16 * AT_LDL; LAS u16* PW = L1H;
    const int orow = lane >> 2, opart = lane & 3;
    const int vrow = lane >> 4, vpc = lane & 15;
    u32x4 qr[4], kr[2][4], vr[8];
#define AT_LOAD_V(bb, hh, kbb) do { _Pragma("unroll") for (int p = 0; p < 8; ++p) vr[p] = *(const u32x4*)(SV + ((size_t)(bb) * SEQ + (size_t)(kbb) * 32 + 4 * p + vrow) * DM + (hh) * 128 + 8 * vpc); } while (0)
#define AT_LOAD_Q(bb, hh, rtt) do { const size_t t_ = (size_t)(bb) * SEQ + (size_t)(rtt) * 16; \
        _Pragma("unroll") for (int ks = 0; ks < 4; ++ks) qr[ks] = *(const u32x4*)(SQ + (t_ + c16) * DM + (hh) * 128 + 32 * ks + 8 * g); } while (0)
#define AT_LOAD_K(bb, hh, kbb) do { const size_t t_ = (size_t)(bb) * SEQ + (size_t)(kbb) * 32; \
        _Pragma("unroll") for (int st = 0; st < 2; ++st) _Pragma("unroll") for (int ks = 0; ks < 4; ++ks) kr[st][ks] = *(const u32x4*)(SK + (t_ + 16 * st + c16) * DM + (hh) * 128 + 32 * ks + 8 * g); } while (0)
    { const int wi0 = blockIdx.x * 8 + wave; if (wi0 < NWI) { const int rt0 = wi0 & 255, h0 = (wi0 >> 8) & 7, b0 = wi0 >> 11; AT_LOAD_Q(b0, h0, rt0); AT_LOAD_K(b0, h0, rt0 >> 1); AT_LOAD_V(b0, h0, rt0 >> 1); } }
    for (int wi = blockIdx.x * 8 + wave; wi < NWI; wi += NW) {
        const int rt = wi & 255, h = (wi >> 8) & 7, b = wi >> 11;
        const size_t tok0 = (size_t)b * SEQ + (size_t)rt * 16;
        const int kb0 = rt >> 1;
        bf16x8 qf[4];
        {
            float ss = 0.f;
#pragma unroll
            for (int ks = 0; ks < 4; ++ks) ss = sumsq8(qr[ks], ss);
            ss += __shfl_xor(ss, 16); ss += __shfl_xor(ss, 32);
            const float rs = __builtin_amdgcn_rsqf(ss * (1.f / 128.f) + EPS);
#pragma unroll
            for (int ks = 0; ks < 4; ++ks) {
                const int d0 = 32 * ks + 8 * g;
                const f32x4 w0 = *(const f32x4*)(a.qn_w + d0) * *(const f32x4*)(a.kn_w + d0) * 0.08838834764831845f, w1 = *(const f32x4*)(a.qn_w + d0 + 4) * *(const f32x4*)(a.kn_w + d0 + 4) * 0.08838834764831845f;
                const f32x4 v0 = (f32x4){bflo(qr[ks].x), bfhi(qr[ks].x), bflo(qr[ks].y), bfhi(qr[ks].y)} * w0 * rs, v1 = (f32x4){bflo(qr[ks].z), bfhi(qr[ks].z), bflo(qr[ks].w), bfhi(qr[ks].w)} * w1 * rs;
                const u32x4 pk = pack8(v0, v1); qf[ks] = __builtin_bit_cast(bf16x8, pk); }
        }
        f32x4 oacc[8];
#pragma unroll
        for (int et = 0; et < 8; ++et) oacc[et] = (f32x4){0.f, 0.f, 0.f, 0.f};
        float carry[4] = {0.f, 0.f, 0.f, 0.f};
        for (int kb = kb0; kb >= 0; --kb) {
            bf16x8 kf[2][4]; float rk[2];
#pragma unroll
            for (int st = 0; st < 2; ++st) { float ss = 0.f;
#pragma unroll
                for (int ks = 0; ks < 4; ++ks) { const u32x4 w = kr[st][ks]; kf[st][ks] = __builtin_bit_cast(bf16x8, w); ss = sumsq8(w, ss); }
                ss += __shfl_xor(ss, 16); ss += __shfl_xor(ss, 32);
                rk[st] = __builtin_amdgcn_rsqf(ss * (1.f / 128.f) + EPS); }
            if (kb != kb0) AT_LOAD_V(b, h, kb);
            if (kb > 0) AT_LOAD_K(b, h, kb - 1);
            f32x4 lb[2], l1v[2];
#pragma unroll
            for (int st = 0; st < 2; ++st) {
                f32x4 z = (f32x4){0.f, 0.f, 0.f, 0.f};
#pragma unroll
                for (int ks = 0; ks < 4; ++ks) z = MFMA16(qf[ks], kf[st][ks], z);
                const int sg = kb * 32 + 16 * st + c16;
#pragma unroll
                for (int i = 0; i < 4; ++i) { const int tg = rt * 16 + 4 * g + i;
                    const float zz = z[i] * rk[st];
                    const float sp = softplus_fast(zz);
                    lb[st][i] = zz - sp; l1v[st][i] = sg < tg ? -sp : 0.f; }
            }
            float tot[4];
#pragma unroll
            for (int i = 0; i < 4; ++i) {
                const float t1 = row16_sum(l1v[1][i]), t0 = row16_sum(l1v[0][i]);
                const float b0 = row16_suffix(l1v[0][i]) - l1v[0][i] + t1, b1 = row16_suffix(l1v[1][i]) - l1v[1][i];
                tot[i] = t0 + t1;
                const int tg = rt * 16 + 4 * g + i;
                const float a0 = (kb * 32 + c16) < tg ? __expf(lb[0][i] + b0 + carry[i]) : 0.f, a1 = (kb * 32 + 16 + c16) < tg ? __expf(lb[1][i] + b1 + carry[i]) : 0.f;
                PW[(4 * g + i) * AT_LDL + c16] = f2bf(a0); PW[(4 * g + i) * AT_LDL + 16 + c16] = f2bf(a1);
            }
#pragma unroll
            for (int i = 0; i < 4; ++i) carry[i] += tot[i];
#pragma unroll
            for (int p = 0; p < 8; ++p) *(LAS u32x4*)(VA + (4 * p + vrow) * AT_LD + 8 * vpc) = vr[p];
            LDS_FENCE();
            { const bf16x8 pa = row_frag(PW, AT_LDL, c16, 8 * g);
#pragma unroll
              for (int et = 0; et < 8; ++et) oacc[et] = MFMA16(pa, tr_frag(VA, AT_LD, 0, 16 * et, lane), oacc[et]); }
            const float wm = fmaxf(fmaxf(carry[0], carry[1]), fmaxf(carry[2], carry[3]));
            if (__builtin_amdgcn_ballot_w64(wm >= -SB_CUT) == 0ull) break;
        }
        const size_t go = (tok0 + orow) * DM + h * 128 + opart * 32;
        u32x4 gsr[4];
#pragma unroll
        for (int j = 0; j < 4; ++j) gsr[j] = *(const u32x4*)(GS + go + 8 * j);
        { const int win = wi + NW; if (win < NWI) { const int rtn = win & 255, hn = (win >> 8) & 7, bn = win >> 11; AT_LOAD_Q(bn, hn, rtn); AT_LOAD_K(bn, hn, rtn >> 1); AT_LOAD_V(bn, hn, rtn >> 1); } }
        LDS_FENCE();
#pragma unroll
        for (int et = 0; et < 8; ++et)
#pragma unroll
            for (int i = 0; i < 4; ++i) VA[(4 * g + i) * AT_LD + 16 * et + c16] = f2bf(oacc[et][i]);
        LDS_FENCE();
#pragma unroll
        for (int j = 0; j < 4; ++j) { const u32x4 o = *(const LAS u32x4*)(VA + orow * AT_LD + opart * 32 + 8 * j); const u32x4 gw = gsr[j];
            f32x4 v0 = (f32x4){bflo(o.x) * bflo(gw.x), bfhi(o.x) * bfhi(gw.x), bflo(o.y) * bflo(gw.y), bfhi(o.y) * bfhi(gw.y)};
            f32x4 v1 = (f32x4){bflo(o.z) * bflo(gw.z), bfhi(o.z) * bfhi(gw.z), bflo(o.w) * bflo(gw.w), bfhi(o.w) * bfhi(gw.w)};
            *(u32x4*)(SQ + go + 8 * j) = pack8(v0, v1); }
        LDS_FENCE();
    }
#undef AT_LOAD_Q
#undef AT_LOAD_V
#undef AT_LOAD_K
}

DI void scale_rows_part(u16* YM, const float* SSQ, int row0, int nrows, int lane, int wave) {
    f32x4 s[4]; u32x4 w[4][2];
#pragma unroll
    for (int q = 0; q < 4; ++q) { const int m = row0 + wave + 8 * q;
        s[q] = *(const f32x4*)(SSQ + (size_t)m * 16 + (lane >> 4) * 4);
        const u16* p = YM + (size_t)m * DM + lane * 16; w[q][0] = *(const u32x4*)p; w[q][1] = *(const u32x4*)(p + 8); }
#pragma unroll
    for (int q = 0; q < 4; ++q) { const int m = row0 + wave + 8 * q;
        const float rs = 1.0f / sqrtf(((s[q].x + s[q].y) + (s[q].z + s[q].w)) * (1.f / 256.f) + EPS);
        u16* p = YM + (size_t)m * DM + lane * 16;
#pragma unroll
        for (int j = 0; j < 2; ++j) { const u32x4 x = w[q][j];
            f32x4 v0 = (f32x4){bflo(x.x), bfhi(x.x), bflo(x.y), bfhi(x.y)} * rs, v1 = (f32x4){bflo(x.z), bfhi(x.z), bflo(x.w), bfhi(x.w)} * rs;
            *(u32x4*)(p + 8 * j) = pack8(v0, v1); } }
    (void)nrows;
}
struct EpiGateScale {
    static constexpr bool PERM = true;
    EpiAct<1> base; u16* YM; const float* SSQ; mutable int k;
    DI void operator()(const AccT& acc, const Unit& u, int wr, int wc, int fr, int fq) const {
        base(acc, u, wr, wc, fr, fq);
        const int tid = threadIdx.x;
        if (k < 8) scale_rows_part(YM, SSQ, (int)blockIdx.x * 256 + 32 * k, 32, tid & 63, tid >> 6);
        ++k;
    }
};

#define XB_TMO      128
#define XB_XCNT(j)  (256  + 64 * (j))
#define XB_XSUB(j)  (1280 + 64 * (j))
#define XB_XGEN(j)  (2304 + 64 * (j))
#define XB_TOP      3328
#define XB_TOPGEN   3392
#define XCD_BAR_WORDS 3456
#define XB_SPIN_CAP (1u << 18)

__device__ __forceinline__ unsigned xb_ld(unsigned* p)              { return __hip_atomic_load(p, __ATOMIC_RELAXED, __HIP_MEMORY_SCOPE_AGENT); }
__device__ __forceinline__ unsigned xb_add(unsigned* p, unsigned v) { return __hip_atomic_fetch_add(p, v, __ATOMIC_RELAXED, __HIP_MEMORY_SCOPE_AGENT); }
__device__ __forceinline__ unsigned xb_xcc_id() { return (unsigned)__builtin_amdgcn_s_getreg((3 << 11) | 20) & 0xFu; }
#define XB_SPIN(cond, bar) do { unsigned _sp = 0; while (cond) { __builtin_amdgcn_s_sleep(1); \
    if ((++_sp & 255u) == 0u) { if (xb_ld(&(bar)[XB_TMO])) break; if (_sp > XB_SPIN_CAP) { atomicAdd(&(bar)[XB_TMO], 1u); break; } } } } while (0)

struct XcdBarrier {
    unsigned* bar; unsigned x;
    volatile LAS unsigned* st;
};

__device__ __forceinline__ XcdBarrier xcd_barrier_post(unsigned* bar, volatile LAS unsigned* st) {
    XcdBarrier b; b.bar = bar; b.x = xb_xcc_id(); b.st = st;
    if (threadIdx.x == 0) (void)xb_add(&bar[XB_XCNT(b.x)], 1u);
    return b;
}
__device__ __forceinline__ void xcd_barrier_complete(unsigned* bar, unsigned x, unsigned& nloc, unsigned& nx) {
    const unsigned G = gridDim.x * gridDim.y * gridDim.z;
    unsigned sum, cnt, mine, sp = 0u;
    for (;;) {
        sum = 0u; cnt = 0u; mine = 0u;
#pragma unroll
        for (unsigned j = 0; j < 16; ++j) { const unsigned c = xb_ld(&bar[XB_XCNT(j)]); sum += c; cnt += (c > 0u) ? 1u : 0u; mine = (j == x) ? c : mine; }
        if (sum == G) break;
        __builtin_amdgcn_s_sleep(1);
        if ((++sp & 255u) == 0u) { if (xb_ld(&bar[XB_TMO])) break; if (sp > XB_SPIN_CAP) { atomicAdd(&bar[XB_TMO], 1u); break; } }
    }
    nloc = mine > 0u ? mine : 1u; nx = cnt > 0u ? cnt : 1u;
}

__device__ __forceinline__ void xcd_barrier(const XcdBarrier& b) {
    asm volatile("s_waitcnt vmcnt(0)" ::: "memory");
    __syncthreads();
    if (threadIdx.x == 0) {
        unsigned* bar = b.bar;
        __builtin_amdgcn_s_waitcnt(0);
        unsigned nloc = b.st[0], nx = b.st[1];
        if (nloc == 0u) { xcd_barrier_complete(bar, b.x, nloc, nx); b.st[0] = nloc; b.st[1] = nx; }
        const unsigned old = xb_add(&bar[XB_XSUB(b.x)], 1u);
        const unsigned gen = old / nloc;
        if (old + 1u == (gen + 1u) * nloc) {
            __builtin_amdgcn_fence(__ATOMIC_RELEASE, "agent");
            asm volatile("s_waitcnt vmcnt(0)" ::: "memory");
            const unsigned og = xb_add(&bar[XB_TOP], 1u);
            const unsigned tg = og / nx;
            if (og + 1u == (tg + 1u) * nx) xb_add(&bar[XB_TOPGEN], 1u);
            else XB_SPIN(xb_ld(&bar[XB_TOPGEN]) == tg, bar);
            __builtin_amdgcn_fence(__ATOMIC_ACQUIRE, "agent");
            xb_add(&bar[XB_XGEN(b.x)], 1u);
            asm volatile("s_waitcnt vmcnt(0)" ::: "memory");
        } else {
            XB_SPIN(xb_ld(&bar[XB_XGEN(b.x)]) == gen, bar);
            __builtin_amdgcn_fence(__ATOMIC_ACQUIRE, "agent");
            asm volatile("s_waitcnt vmcnt(0)" ::: "memory");
        }
    }
    __syncthreads();
}


__global__ void __launch_bounds__(512, 2) fwd_kernel(Args a) {
    extern __shared__ __attribute__((aligned(16))) unsigned char lds_raw[];
    LAS unsigned char* lds = (LAS unsigned char*)lds_raw;
    cg::grid_group grid = cg::this_grid();
    const int tid = threadIdx.x, lane = tid & 63, wave = __builtin_amdgcn_readfirstlane(tid >> 6);
    const int G = gridDim.x, lo = a.ph_lo, hi = a.ph_hi;
    unsigned char* ws = a.ws;
    u16* WALL = (u16*)(ws + WS_WALL); const float* BIAS = (const float*)(ws + WS_BIAS); u16* HB = (u16*)(ws + WS_H); u16* B6 = (u16*)(ws + WS_B6);
#define IN(k) (lo <= (k) && (k) < hi)
    volatile LAS unsigned* xst = (volatile LAS unsigned*)(lds + LDS_BYTES - 64);
    if (tid < 2) xst[tid] = 0u;
    __syncthreads();
    XcdBarrier xbar = xcd_barrier_post((unsigned*)(ws + WS_BAR), xst);
    if (hi > 1000) grid.sync();
#define SEAM(k) do { if (IN(k) && IN((k) + 1)) xcd_barrier(xbar); } while (0)
    if (IN(0)) { p0_prologue(a, lds, tid, lane, wave); }
    SEAM(0);
    if (IN(1)) {
        { pg8::Gemm g{HB, WALL, MT, 6144, DM}; pg8::StaticOrder S; S.init(MT, 6144, G, (int)blockIdx.x);
          EpiPlain E{B6, BIAS}; pg8::gemm_phase(lds, g, S, E); }
        { pg8::Gemm g{HB, WALL + (size_t)6144 * DM, MT, 2048, DM}; pg8::StaticOrder S; S.init(MT, 2048, G, (int)blockIdx.x);
          EpiGateM E{(u16*)a.out, BIAS + 6144}; pg8::gemm_phase(lds, g, S, E); }
        { pg8::Gemm g{HB, WALL + (size_t)8192 * DM, MT, 1024, DM}; pg8::StaticOrder S; S.init(MT, 1024, G, (int)blockIdx.x);
          EpiAct<0> E{(u16*)a.out + TS, BIAS + 8192}; pg8::gemm_phase(lds, g, S, E); }
    }
    SEAM(1);
    if (IN(2)) {
#ifndef SKIP_ML
        for (int it = blockIdx.x; it < NB * 4 * 4; it += G) mlstm_item(a, lds, it, tid, wave);
#endif
#ifndef SKIP_AT
        __syncthreads();
        attn_phase(a, lds, lane, wave);
#endif
        __syncthreads();
    }
    SEAM(2);
    if (IN(3)) {
        pg8::Gemm g{HB, WALL + (size_t)N1 * DM, MT, 2048, DM}; pg8::StaticOrder S; S.init(MT, 2048, G, (int)blockIdx.x);
        EpiGateScale E{EpiAct<1>{B6, BIAS + N1}, B6 + 2 * TS, (const float*)(ws + WS_SSQ), 0};
        pg8::gemm_phase(lds, g, S, E);
        for (int k = E.k; k < 8; ++k) scale_rows_part(B6 + 2 * TS, (const float*)(ws + WS_SSQ), (int)blockIdx.x * 256 + 32 * k, 32, lane, wave);
    }
    SEAM(3);
    if (IN(4)) {
        u16* T1 = B6 + 5 * TS;
        { pg8::Gemm g{B6 + 2 * TS, (const u16*)(ws + WS_WPM), MT, DM, DM}; pg8::StaticOrder S; S.init(MT, DM, G, (int)blockIdx.x);
          EpiMerge<false> E{B6, T1, B6 + 4 * TS}; pg8::gemm_phase(lds, g, S, E); }
        { pg8::Gemm g{B6 + 3 * TS, (const u16*)(ws + WS_WPS), MT, DM, DM}; pg8::StaticOrder S; S.init(MT, DM, G, (int)blockIdx.x);
          EpiMerge<true> E{B6 + TS, T1, B6 + 4 * TS}; pg8::gemm_phase(lds, g, S, E); }
    }
    SEAM(4);
    if (IN(5)) {
        pg8::Gemm g{B6 + 4 * TS, (const u16*)(ws + WS_WOUT), MT, DM, DM}; pg8::StaticOrder S; S.init(MT, DM, G, (int)blockIdx.x);
        EpiOut E{a.x, a.out};
        pg8::gemm_phase(lds, g, S, E);
    }
#undef IN
#undef SEAM
}

extern "C" void kernel_launch(void* const* d_in, const int* in_sizes, int n_in, void* d_out, int out_size, void* d_ws, size_t ws_size, hipStream_t stream) {
    static int grid = 0;
    if (grid == 0) {
        if (n_in != 12 || in_sizes[0] != MT * DM || out_size != MT * DM || ws_size < WS_END) {
            fprintf(stderr, "kernel_launch: unexpected shapes (n_in %d, in0 %d, out %d, ws %zu); nothing launched\n", n_in, n_in > 0 ? in_sizes[0] : -1, out_size, ws_size); grid = -1; return; }
        int dev = 0, cus = 0, per_cu = 0;
        hipGetDevice(&dev); hipDeviceGetAttribute(&cus, hipDeviceAttributeMultiprocessorCount, dev);
        if (hipFuncSetAttribute((const void*)fwd_kernel, hipFuncAttributeMaxDynamicSharedMemorySize, LDS_BYTES) != hipSuccess) { fprintf(stderr, "kernel_launch: hipFuncSetAttribute failed\n"); grid = -1; return; }
        if (hipOccupancyMaxActiveBlocksPerMultiprocessor(&per_cu, (const void*)fwd_kernel, 512, LDS_BYTES) != hipSuccess || per_cu < 1) { fprintf(stderr, "kernel_launch: occupancy query says %d\n", per_cu); per_cu = 1; }
        (void)hipGetLastError();
        grid = cus;
    }
    if (grid < 0) return;
    Args a{};
    a.x = (const float*)d_in[0]; a.norm_w = (const float*)d_in[1]; a.w_in = (const float*)d_in[2]; a.b_in = (const float*)d_in[3]; a.conv_w = (const float*)d_in[4]; a.conv_b = (const float*)d_in[5];
    a.mnorm_w = (const float*)d_in[6]; a.qn_w = (const float*)d_in[7]; a.kn_w = (const float*)d_in[8]; a.w_pm = (const float*)d_in[9]; a.w_ps = (const float*)d_in[10]; a.w_out = (const float*)d_in[11];
    a.out = (float*)d_out; a.ws = (unsigned char*)d_ws;
    if (hipMemsetAsync(d_ws, 0, WS_BAR + WS_BAR_BYTES, stream) != hipSuccess) { fprintf(stderr, "kernel_launch: hipMemsetAsync failed\n"); return; }
#if MK_N_LAUNCHES == 1
    a.ph_lo = 0; a.ph_hi = NPH;
    void* args[] = {&a};
    hipError_t e = hipLaunchCooperativeKernel((const void*)fwd_kernel, dim3(grid), dim3(512), args, LDS_BYTES, stream);
    if (e != hipSuccess) fprintf(stderr, "kernel_launch: cooperative launch failed: %s (grid %d)\n", hipGetErrorString(e), grid);
#else
    for (int p = 0; p < NPH; ++p) { a.ph_lo = p; a.ph_hi = p + 1; hipLaunchKernelGGL(fwd_kernel, dim3(grid), dim3(512), LDS_BYTES, stream, a); }
#endif
}
```
